# Optimizing an MI355X kernel written in HIP

```python
import jax, jax.numpy as jnp
from jax import lax
import numpy as np

D_MODEL = 2048
BATCH = 4
SEQ = 4096
DEPTH = 2

CHUNK = 64
Q_BLOCK = 128
MEM_LEN = 256
N_A_LAYERS = DEPTH // 2
N_B_LAYERS = DEPTH - N_A_LAYERS

MIX_WIDTH = D_MODEL
MEM_HEADS = 4
MEM_HEAD_DIM = D_MODEL // 16
MEM_WIDTH = MEM_HEADS * MEM_HEAD_DIM
TOK_WIDTH = MIX_WIDTH - MEM_WIDTH

LRU_WIDTH = TOK_WIDTH
LRU_BLOCKS = 12
LRU_BLOCK_DIM = LRU_WIDTH // LRU_BLOCKS
CONV_WIDTH = 4
LRU_C = 8.0

V_HEAD_DIM = 128
MLA_HEADS = TOK_WIDTH // V_HEAD_DIM
QK_NOPE_DIM = 128
QK_ROPE_DIM = 64
QK_HEAD_DIM = QK_NOPE_DIM + QK_ROPE_DIM
Q_LORA_RANK = 768
KV_LORA_RANK = 512
ROPE_THETA = 10000.0

A_IN_WIDTH = 2 * LRU_WIDTH + MEM_WIDTH
B_IN_WIDTH = Q_LORA_RANK + MEM_WIDTH

D_FF = 4 * D_MODEL
EPS = 1e-6

kernel_name = "yoco_rglru_mla_memory_trunk"


def rms_norm(x, g):
    xf = x.astype(jnp.float32)
    xf = xf * lax.rsqrt(jnp.mean(xf * xf, axis=-1, keepdims=True) + EPS)
    return xf.astype(x.dtype) * g


def rope_tables(positions):
    half = QK_ROPE_DIM // 2
    inv_freq = ROPE_THETA ** (-jnp.arange(half, dtype=jnp.float32) / half)
    ang = positions.astype(jnp.float32)[..., None] * inv_freq
    return jnp.cos(ang), jnp.sin(ang)


def apply_rope(x, cos, sin):
    half = QK_ROPE_DIM // 2
    x1, x2 = x[..., :half], x[..., half:]
    c = cos.astype(x.dtype)
    s = sin.astype(x.dtype)
    return jnp.concatenate([x1 * c - x2 * s, x2 * c + x1 * s], axis=-1)


def rglru_mixer(xb, gate, conv_w, conv_b, w_r, b_r, w_i, b_i, lam):
    B, S, C = xb.shape
    xc = lax.conv_general_dilated(
        xb, conv_w[:, None, :], window_strides=(1,), padding=[(CONV_WIDTH - 1, 0)],
        dimension_numbers=('NWC', 'WIO', 'NWC'), feature_group_count=C) + conv_b
    xh = xc.reshape(B, S, LRU_BLOCKS, LRU_BLOCK_DIM)
    r = jax.nn.sigmoid(jnp.einsum('bsnd,nde->bsne', xh, w_r).reshape(B, S, C) + b_r)
    i = jax.nn.sigmoid(jnp.einsum('bsnd,nde->bsne', xh, w_i).reshape(B, S, C) + b_i)
    log_a = (-LRU_C * r.astype(jnp.float32)) * jax.nn.softplus(-lam.astype(jnp.float32))
    a = jnp.exp(log_a)
    b = jnp.sqrt(-jnp.expm1(2.0 * log_a)) * (i * xc).astype(jnp.float32)

    def combine(left, right):
        return (left[0] * right[0], right[0] * left[1] + right[1])

    _, h = lax.associative_scan(combine, (a, b), axis=1)
    return h.astype(xb.dtype) * jax.nn.gelu(gate)


def shared_mla_kv(h, g_in, w_down, g_latent, w_up, cos, sin):
    B, S, _ = h.shape
    ckv = rms_norm(h, g_in) @ w_down
    latent = rms_norm(ckv[..., :KV_LORA_RANK], g_latent)
    k_pe = apply_rope(ckv[..., KV_LORA_RANK:], cos, sin)
    kv = (latent @ w_up).reshape(B, S, MLA_HEADS, QK_NOPE_DIM + V_HEAD_DIM)
    return kv[..., :QK_NOPE_DIM], k_pe, kv[..., QK_NOPE_DIM:]


def mla_block_causal(q_nope, q_pe, k_nope, k_pe, v):
    B, S, H, _ = q_nope.shape
    scale = QK_HEAD_DIM ** -0.5
    outs = []
    for blk in range(S // Q_BLOCK):
        q0 = blk * Q_BLOCK
        kl = q0 + Q_BLOCK
        s = (jnp.einsum('bqhd,bkhd->bhqk', q_nope[:, q0:kl], k_nope[:, :kl])
             + jnp.einsum('bqhd,bkd->bhqk', q_pe[:, q0:kl], k_pe[:, :kl])).astype(jnp.float32) * scale
        q_chunk = (q0 + jnp.arange(Q_BLOCK)) // CHUNK
        k_chunk = jnp.arange(kl) // CHUNK
        mask = k_chunk[None, :] <= q_chunk[:, None]
        p = jax.nn.softmax(jnp.where(mask, s, -1e30), axis=-1).astype(v.dtype)
        outs.append(jnp.einsum('bhqk,bkhd->bqhd', p, v[:, :kl]))
    return jnp.concatenate(outs, axis=1).reshape(B, S, H * V_HEAD_DIM)


def memory_attention(qm, mk, mv):
    B, S, _ = qm.shape
    q = qm.reshape(B, S, MEM_HEADS, MEM_HEAD_DIM)
    s = jnp.einsum('bshd,bmhd->bhsm', q, mk).astype(jnp.float32) * (MEM_HEAD_DIM ** -0.5)
    p = jax.nn.softmax(s, axis=-1).astype(mv.dtype)
    return jnp.einsum('bhsm,bmhd->bshd', p, mv).reshape(B, S, MEM_WIDTH)


def setup_inputs(seed: int = 0) -> dict:
    key = jax.random.key(seed)
    ks = iter(jax.random.split(key, 40))
    nrm = lambda shape, scale: jax.random.normal(next(ks), shape, jnp.float32) * scale
    gain = lambda shape: 1.0 + 0.05 * jax.random.normal(next(ks), shape, jnp.float32)

    x = jax.random.normal(next(ks), (BATCH, SEQ, D_MODEL), jnp.float32)
    mem = jax.random.normal(next(ks), (BATCH, MEM_LEN, D_MODEL), jnp.float32)
    offset = jax.random.randint(next(ks), (BATCH, 1), 0, 64) * CHUNK
    positions = (offset + jnp.arange(SEQ)[None, :]).astype(jnp.int32)

    u = jax.random.uniform(next(ks), (N_A_LAYERS, LRU_WIDTH), jnp.float32, minval=0.9, maxval=0.999)
    a0 = u ** (1.0 / LRU_C)
    a_lambda = jnp.log(a0) - jnp.log1p(-a0)

    return {
        "x": x, "mem": mem, "positions": positions,
        "g_mix_pre": gain((DEPTH, D_MODEL)),
        "g_mix_post": gain((DEPTH, D_MODEL)),
        "g_mlp_pre": gain((DEPTH, D_MODEL)),
        "g_mlp_post": gain((DEPTH, D_MODEL)),
        "g_mem": gain((DEPTH, D_MODEL)),
        "w_mem_k": nrm((DEPTH, D_MODEL, MEM_WIDTH), D_MODEL ** -0.5),
        "w_mem_v": nrm((DEPTH, D_MODEL, MEM_WIDTH), D_MODEL ** -0.5),
        "w_o": nrm((DEPTH, MIX_WIDTH, D_MODEL), MIX_WIDTH ** -0.5),
        "w_ff1": nrm((DEPTH, D_MODEL, D_FF), D_MODEL ** -0.5),
        "w_ff2": nrm((DEPTH, D_FF, D_MODEL), D_FF ** -0.5),
        "a_w_in": nrm((N_A_LAYERS, D_MODEL, A_IN_WIDTH), D_MODEL ** -0.5),
        "a_conv_w": nrm((N_A_LAYERS, CONV_WIDTH, LRU_WIDTH), CONV_WIDTH ** -0.5),
        "a_conv_b": nrm((N_A_LAYERS, LRU_WIDTH), 0.01),
        "a_w_rgate": nrm((N_A_LAYERS, LRU_BLOCKS, LRU_BLOCK_DIM, LRU_BLOCK_DIM), LRU_BLOCK_DIM ** -0.5),
        "a_b_rgate": nrm((N_A_LAYERS, LRU_WIDTH), 0.01),
        "a_w_igate": nrm((N_A_LAYERS, LRU_BLOCKS, LRU_BLOCK_DIM, LRU_BLOCK_DIM), LRU_BLOCK_DIM ** -0.5),
        "a_b_igate": nrm((N_A_LAYERS, LRU_WIDTH), 0.01),
        "a_lambda": a_lambda,
        "b_w_in": nrm((N_B_LAYERS, D_MODEL, B_IN_WIDTH), D_MODEL ** -0.5),
        "b_g_qa": gain((N_B_LAYERS, Q_LORA_RANK)),
        "b_w_qb": nrm((N_B_LAYERS, Q_LORA_RANK, MLA_HEADS * QK_HEAD_DIM), Q_LORA_RANK ** -0.5),
        "kv_g_in": gain((D_MODEL,)),
        "kv_w_down": nrm((D_MODEL, KV_LORA_RANK + QK_ROPE_DIM), D_MODEL ** -0.5),
        "kv_g_latent": gain((KV_LORA_RANK,)),
        "kv_w_up": nrm((KV_LORA_RANK, MLA_HEADS * (QK_NOPE_DIM + V_HEAD_DIM)), KV_LORA_RANK ** -0.5),
    }


def reference(x, mem, positions,
              g_mix_pre, g_mix_post, g_mlp_pre, g_mlp_post, g_mem, w_mem_k, w_mem_v, w_o, w_ff1, w_ff2,
              a_w_in, a_conv_w, a_conv_b, a_w_rgate, a_b_rgate, a_w_igate, a_b_igate, a_lambda,
              b_w_in, b_g_qa, b_w_qb,
              kv_g_in, kv_w_down, kv_g_latent, kv_w_up):
    B, S, _ = x.shape
    cos, sin = rope_tables(positions)
    h = x
    shared = None
    for layer in range(DEPTH):
        hn = rms_norm(h, g_mix_pre[layer])
        mn = rms_norm(mem, g_mem[layer])
        mk = (mn @ w_mem_k[layer]).reshape(B, MEM_LEN, MEM_HEADS, MEM_HEAD_DIM)
        mv = (mn @ w_mem_v[layer]).reshape(B, MEM_LEN, MEM_HEADS, MEM_HEAD_DIM)
        if layer < N_A_LAYERS:
            la = layer
            proj = hn @ a_w_in[la]
            xb = proj[..., :LRU_WIDTH]
            gate = proj[..., LRU_WIDTH:2 * LRU_WIDTH]
            qm = proj[..., 2 * LRU_WIDTH:]
            tok = rglru_mixer(xb, gate, a_conv_w[la], a_conv_b[la], a_w_rgate[la], a_b_rgate[la],
                              a_w_igate[la], a_b_igate[la], a_lambda[la])
        else:
            lb = layer - N_A_LAYERS
            if shared is None:
                shared = shared_mla_kv(h, kv_g_in, kv_w_down, kv_g_latent, kv_w_up, cos, sin)
            k_nope, k_pe, v = shared
            proj = hn @ b_w_in[lb]
            cq = rms_norm(proj[..., :Q_LORA_RANK], b_g_qa[lb])
            qm = proj[..., Q_LORA_RANK:]
            q = (cq @ b_w_qb[lb]).reshape(B, S, MLA_HEADS, QK_HEAD_DIM)
            q_nope = q[..., :QK_NOPE_DIM]
            q_pe = apply_rope(q[..., QK_NOPE_DIM:], cos[:, :, None, :], sin[:, :, None, :])
            tok = mla_block_causal(q_nope, q_pe, k_nope, k_pe, v)
        mem_out = memory_attention(qm, mk, mv)
        y = jnp.concatenate([tok, mem_out], axis=-1) @ w_o[layer]
        h = h + rms_norm(y, g_mix_post[layer])
        f = rms_norm(h, g_mlp_pre[layer]) @ w_ff1[layer]
        f = jnp.square(jax.nn.relu(f)) @ w_ff2[layer]
        h = h + rms_norm(f, g_mlp_post[layer])
    return h
```

```cpp
#include <hip/hip_runtime.h>
#include <hip/hip_cooperative_groups.h>
#include <cstdio>
#include <cstdint>
#include <cmath>
namespace cg = cooperative_groups;

#define LAS __attribute__((address_space(3)))
typedef unsigned short bf16_t;
typedef short bf16x8 __attribute__((ext_vector_type(8)));
typedef short s16x4 __attribute__((ext_vector_type(4)));
typedef float f32x4 __attribute__((ext_vector_type(4)));
typedef float f32x16 __attribute__((ext_vector_type(16)));
typedef unsigned u32x4 __attribute__((ext_vector_type(4)));
typedef unsigned u32x2 __attribute__((ext_vector_type(2)));

constexpr int T = 16384, DM = 2048, SEQ = 4096, NBATCH = 4;
constexpr float EPS = 1e-6f;
constexpr float MEMSCALE = 0.08838834764831845f * 1.4426950408889634f;
constexpr float QSCALE = 0.07216878364870322f * 1.4426950408889634f;
constexpr size_t MiB = 1u << 20;
constexpr size_t WS_RSTD = 0, WS_SSQCQ = 65536, WS_SSQLAT = 131072, WS_RSTDMEM = 196608;
constexpr size_t WS_BAR = 262144;
constexpr size_t WS_SSQY = 320 * 1024, WS_SSQH = 576 * 1024, WS_CNT = 832 * 1024, WS_CTL_ZERO_END = 896 * 1024;
constexpr size_t WS_MEMKV = 1 * MiB;
constexpr size_t WS_COS = 5 * MiB, WS_SIN = 7 * MiB;
constexpr int LDF = 8192 + 64;
constexpr size_t KiB = 1024;
constexpr size_t WS_WAIN = 9 * MiB, WS_WO0 = 23 * MiB, WS_WFF1_0 = 31 * MiB, WS_WFF2_0 = 63 * MiB, WS_WGATE = 95 * MiB + 256 * KiB, WS_WMEM0 = 96 * MiB + 768 * KiB, WS_WMEM1 = 100 * MiB + 768 * KiB,
                 WS_WO1 = 104 * MiB + 768 * KiB, WS_WFF1_1 = 112 * MiB + 768 * KiB, WS_WFF2_1 = 144 * MiB + 768 * KiB, WS_WBIN = 177 * MiB, WS_WQB = 185 * MiB, WS_WUP = 188 * MiB + 384 * KiB;
static_assert(WS_WFF2_0 + (size_t)2048 * LDF * 2 <= WS_WGATE && WS_WFF2_1 + (size_t)2048 * LDF * 2 <= WS_WBIN && WS_WUP + 3 * MiB <= 192 * MiB, "weight map");
constexpr size_t WS_HB = 192 * MiB, WS_Y = 256 * MiB, WS_CC = 320 * MiB, WS_ARENA = 384 * MiB, WS_END = 512 * MiB;
constexpr size_t WS_GG = WS_Y;
constexpr size_t WS_MEMB = WS_Y + 48 * MiB;
constexpr size_t WS_XBR = WS_ARENA, WS_QMA = WS_ARENA + 48 * MiB;
constexpr size_t WS_XC = WS_HB;
constexpr size_t WS_RU = WS_ARENA;
constexpr size_t WS_AGG = WS_ARENA + 96 * MiB;
constexpr size_t WS_F = WS_ARENA - 1 * MiB;
constexpr size_t WS_CQ = WS_Y, WS_QMB = WS_Y + 24 * MiB, WS_CKV = WS_Y + 40 * MiB, WS_KPE = WS_Y + 56 * MiB;
constexpr size_t WS_Q = WS_WAIN;
constexpr size_t WS_KV = WS_ARENA;
static_assert(WS_F + (size_t)8192 * LDF * 2 <= WS_END && WS_Q + 72 * MiB <= WS_WMEM1 + 4 * MiB, "map");

namespace pg8 {
constexpr int BM = 256, BK = 64, HALF = 128, HTB = HALF * BK * 2, STAGE_BYTES = 8 * HTB, NXCD = 8, WGM = 8;
__host__ __device__ __forceinline__ int lds_byte(int r, int c) { const int st = (r >> 4) * 2 + (c >> 5), rr = r & 15, cc = c & 31, ob = rr * 64 + cc * 2; return st * 1024 + (ob ^ (((ob >> 9) & 1) << 5)); }
__host__ __device__ __forceinline__ void stage_rc(int b, int& R, int& C) { const int st = b / 1024, sb = b % 1024, swz = sb ^ (((sb >> 9) & 1) << 5); R = (st >> 1) * 16 + swz / 64; C = (st & 1) * 32 + (swz % 64) / 2; }
__host__ __device__ __forceinline__ int perm32(int rho) { const int n = rho >> 4, i = rho & 15; return 8 * (i >> 2) + 4 * n + (i & 3); }

struct Unit { int pm, pn, g; };
struct Gemm { const bf16_t* A; const bf16_t* Bt; int lda, ldb, K; size_t gsA, gsB; };

struct StaticOrder {
    int nM, nN, nwg, G, c, gdiv;
    __device__ void init(int M, int N, int G_, int c_, int gdiv_ = 1 << 20) { nM = M / BM; nN = N / BM; nwg = nM * nN; G = G_; c = c_; gdiv = gdiv_; }
    __device__ bool next(int i, Unit& u) const {
        const long L = (long)i * G + c; if (L >= nwg) return false;
        int wgid = (int)L; { const int q = nwg / NXCD, r = nwg % NXCD, xcd = wgid % NXCD, off = wgid / NXCD; wgid = (xcd < r ? xcd * (q + 1) : r * (q + 1) + (xcd - r) * q) + off; }
        const int nig = WGM * nN, gid = wgid / nig, fm = gid * WGM, gsz = (nM - fm) < WGM ? (nM - fm) : WGM;
        u.pm = fm + ((wgid % nig) % gsz); const int pnv = (wgid % nig) / gsz; u.g = pnv / gdiv; u.pn = pnv - u.g * gdiv; return true;
    }
    __device__ __forceinline__ void a_ready(const Unit&) const {}
    __device__ __forceinline__ void done(const Unit&) const {}
};

__device__ __forceinline__ unsigned cvt_pk_bf16(float lo, float hi) { unsigned r; asm volatile("v_cvt_pk_bf16_f32 %0, %1, %2" : "=v"(r) : "v"(lo), "v"(hi)); return r; }

template <class Epi, class Sched, bool ALIGN_EPI = false, bool SP2 = false>
__device__ __forceinline__ void gemm_phase(LAS unsigned char* lds, const Gemm g, const Sched& S, const Epi& E) {
    int tid_ = threadIdx.x; asm volatile("" : "+v"(tid_));
    const int tid = tid_, wid = __builtin_amdgcn_readfirstlane(tid >> 6), lane = tid & 63, wr = wid >> 2, wc = wid & 3, fr = lane & 15, fq = lane >> 4;
    const int K = g.K, nt = K / BK;
    unsigned voffA[2], voffB[2];
#pragma unroll
    for (int i = 0; i < 2; ++i) { int R, C; stage_rc(tid * 16 + i * 8192, R, C); const int Rb = Epi::PERM ? ((R & ~31) + perm32(R & 31)) : R;
        voffA[i] = (unsigned)(R * g.lda + C) * 2u; voffB[i] = (unsigned)(Rb * g.ldb + C) * 2u; }
    const size_t kstep = (size_t)(BK * 2);
    const size_t hstepA = (size_t)HALF * g.lda * 2, hstepB = (size_t)HALF * g.ldb * 2;
    const size_t tstepA = 2 * hstepA, tstepB = 2 * hstepB;
    const unsigned ldsw = (unsigned)wid * 1024u;
    const int aoff = lds_byte(wr * 64 + fr, fq * 8), boff = lds_byte(wc * 32 + fr, fq * 8);
#define PG8_SA(b, h) (((b) * 2 + (h)) * HTB)
#define PG8_SB(b, h) ((4 + (b) * 2 + (h)) * HTB)
#define PG8_STAGE(bufoff, gbase, voff) do { _Pragma("unroll") for (int _i = 0; _i < 2; ++_i) \
        __builtin_amdgcn_global_load_lds((const unsigned*)((const char*)(gbase) + (voff)[_i]), (LAS unsigned*)(lds + (bufoff) + ldsw + _i * 8192), 16, 0, 0); } while (0)
#define PG8_LDA(dst, b, h) do { _Pragma("unroll") for (int m = 0; m < 4; ++m) _Pragma("unroll") for (int k = 0; k < 2; ++k) dst[m][k] = *(const LAS bf16x8*)(lds + PG8_SA(b, h) + aoff + m * 2048 + k * 1024); } while (0)
#define PG8_LDB(dst, b, h) do { _Pragma("unroll") for (int n = 0; n < 2; ++n) _Pragma("unroll") for (int k = 0; k < 2; ++k) dst[n][k] = *(const LAS bf16x8*)(lds + PG8_SB(b, h) + boff + n * 2048 + k * 1024); } while (0)
#define PG8_MMA(ai, bj, At, Bt) do { __builtin_amdgcn_s_setprio(1); _Pragma("unroll") for (int m = 0; m < 4; ++m) _Pragma("unroll") for (int n = 0; n < 2; ++n) _Pragma("unroll") for (int k = 0; k < 2; ++k) \
        acc[ai][bj][m][n] = __builtin_amdgcn_mfma_f32_16x16x32_bf16(Bt[n][k], At[m][k], acc[ai][bj][m][n], 0, 0, 0); __builtin_amdgcn_s_setprio(0); } while (0)
#define PG8_WAIT_V(n) asm volatile("s_waitcnt vmcnt(" #n ")" ::: "memory")
#define PG8_WAIT_L(n) asm volatile("s_waitcnt lgkmcnt(" #n ")" ::: "memory")
#define PG8_BAR __builtin_amdgcn_s_barrier()
#define PG8_SCHED __builtin_amdgcn_sched_barrier(0)
    Unit cur, nxt; int ui = 0;
    if (!S.next(0, cur)) return;
    f32x4 acc[2][2][4][2];
#pragma unroll
    for (int a = 0; a < 2; ++a)
#pragma unroll
        for (int b = 0; b < 2; ++b)
#pragma unroll
            for (int m = 0; m < 4; ++m)
#pragma unroll
                for (int n = 0; n < 2; ++n) acc[a][b][m][n] = (f32x4){0.f, 0.f, 0.f, 0.f};
    bf16x8 At[4][2], B0[2][2], B1[2][2];
    const char* cA = (const char*)g.A + (size_t)cur.g * g.gsA + (size_t)cur.pm * tstepA; const char* cB = (const char*)g.Bt + (size_t)cur.g * g.gsB + (size_t)cur.pn * tstepB;
    S.a_ready(cur);
    if constexpr (SP2) {
        PG8_STAGE(PG8_SB(0, 0), cB, voffB); PG8_STAGE(PG8_SB(0, 1), cB + hstepB, voffB); PG8_STAGE(PG8_SA(0, 0), cA, voffA); PG8_STAGE(PG8_SA(0, 1), cA + hstepA, voffA);
        if (wr == 1) PG8_BAR;
        PG8_WAIT_V(2); PG8_BAR;
        PG8_STAGE(PG8_SB(1, 0), cB + kstep, voffB); PG8_STAGE(PG8_SA(1, 0), cA + kstep, voffA); PG8_STAGE(PG8_SB(1, 1), cB + hstepB + kstep, voffB);
        PG8_WAIT_V(6); PG8_BAR;
    } else {
        PG8_STAGE(PG8_SB(0, 0), cB, voffB); PG8_STAGE(PG8_SA(0, 0), cA, voffA); PG8_STAGE(PG8_SB(0, 1), cB + hstepB, voffB); PG8_STAGE(PG8_SA(0, 1), cA + hstepA, voffA);
        if (wr == 1) PG8_BAR;
        PG8_WAIT_V(4); PG8_BAR;
        PG8_STAGE(PG8_SB(1, 0), cB + kstep, voffB); PG8_STAGE(PG8_SA(1, 0), cA + kstep, voffA); PG8_STAGE(PG8_SB(1, 1), cB + hstepB + kstep, voffB);
        PG8_WAIT_V(6); PG8_BAR;
    }
    for (;;) {
        const bool has_next = S.next(ui + 1, nxt);
        const char* nA = has_next ? (const char*)g.A + (size_t)nxt.g * g.gsA + (size_t)nxt.pm * tstepA : cA; const char* nB = has_next ? (const char*)g.Bt + (size_t)nxt.g * g.gsB + (size_t)nxt.pn * tstepB : cB;
        for (int t = 0; t < nt; t += 2) {
            const bool last = (t == nt - 2);
            const char* a1 = cA + (size_t)(t + 1) * kstep;
            const char* a2 = last ? nA : cA + (size_t)(t + 2) * kstep; const char* b2 = last ? nB : cB + (size_t)(t + 2) * kstep;
            const char* a3 = a2 + kstep; const char* b3 = b2 + kstep;
            if (last && has_next) S.a_ready(nxt);
            if constexpr (SP2) {
            PG8_LDB(B0, 0, 0); PG8_LDB(B1, 0, 1); PG8_SCHED; PG8_LDA(At, 0, 0); PG8_STAGE(PG8_SA(1, 1), a1 + hstepA, voffA);
            PG8_WAIT_V(8); PG8_WAIT_L(0); PG8_BAR; PG8_MMA(0, 0, At, B0); PG8_MMA(0, 1, At, B1); PG8_BAR; PG8_SCHED;
            PG8_LDA(At, 0, 1); PG8_STAGE(PG8_SB(0, 0), b2, voffB); PG8_STAGE(PG8_SB(0, 1), b2 + hstepB, voffB); PG8_STAGE(PG8_SA(0, 0), a2, voffA);
            PG8_WAIT_V(8); PG8_WAIT_L(0); PG8_BAR; PG8_MMA(1, 0, At, B0); PG8_MMA(1, 1, At, B1); PG8_BAR; PG8_SCHED;
            PG8_LDB(B0, 1, 0); PG8_LDB(B1, 1, 1); PG8_SCHED; PG8_LDA(At, 1, 0); PG8_STAGE(PG8_SA(0, 1), a2 + hstepA, voffA);
            PG8_WAIT_V(8); PG8_WAIT_L(0); PG8_BAR; PG8_MMA(0, 0, At, B0); PG8_MMA(0, 1, At, B1); PG8_BAR; PG8_SCHED;
            PG8_LDA(At, 1, 1); PG8_STAGE(PG8_SB(1, 0), b3, voffB); PG8_STAGE(PG8_SB(1, 1), b3 + hstepB, voffB); PG8_STAGE(PG8_SA(1, 0), a3, voffA);
            PG8_WAIT_V(8); PG8_WAIT_L(0); PG8_BAR; PG8_MMA(1, 0, At, B0); PG8_MMA(1, 1, At, B1); PG8_BAR; PG8_SCHED;
            } else {
            PG8_LDB(B0, 0, 0); PG8_SCHED; PG8_LDA(At, 0, 0); PG8_STAGE(PG8_SA(1, 1), a1 + hstepA, voffA);
            PG8_WAIT_L(8); PG8_BAR; PG8_WAIT_L(0); PG8_MMA(0, 0, At, B0); PG8_BAR; PG8_SCHED;
            PG8_LDB(B1, 0, 1); PG8_STAGE(PG8_SB(0, 0), b2, voffB);
            PG8_BAR; PG8_WAIT_L(0); PG8_MMA(0, 1, At, B1); PG8_BAR;
            PG8_LDA(At, 0, 1); PG8_STAGE(PG8_SA(0, 0), a2, voffA);
            PG8_BAR; PG8_WAIT_L(0); PG8_MMA(1, 0, At, B0); PG8_BAR; PG8_SCHED;
            PG8_STAGE(PG8_SB(0, 1), b2 + hstepB, voffB);
            PG8_WAIT_V(6); PG8_BAR; PG8_MMA(1, 1, At, B1); PG8_BAR;
            PG8_LDB(B0, 1, 0); PG8_SCHED; PG8_LDA(At, 1, 0); PG8_STAGE(PG8_SA(0, 1), a2 + hstepA, voffA);
            PG8_WAIT_L(8); PG8_BAR; PG8_WAIT_L(0); PG8_MMA(0, 0, At, B0); PG8_BAR; PG8_SCHED;
            PG8_LDB(B1, 1, 1); PG8_STAGE(PG8_SB(1, 0), b3, voffB);
            PG8_BAR; PG8_WAIT_L(0); PG8_MMA(0, 1, At, B1); PG8_BAR;
            PG8_LDA(At, 1, 1); PG8_STAGE(PG8_SA(1, 0), a3, voffA);
            PG8_BAR; PG8_WAIT_L(0); PG8_MMA(1, 0, At, B0); PG8_BAR; PG8_SCHED;
            PG8_STAGE(PG8_SB(1, 1), b3 + hstepB, voffB);
            PG8_WAIT_V(6); PG8_BAR; PG8_MMA(1, 1, At, B1); PG8_BAR;
            }
        }
        if constexpr (ALIGN_EPI) { if (wr == 0) PG8_BAR; }
        { int fr2 = fr, fq2 = fq; asm volatile("" : "+v"(fr2), "+v"(fq2)); E(acc, cur, wr, wc, fr2, fq2); } S.done(cur);
        if (!has_next) break;
#pragma unroll
        for (int a = 0; a < 2; ++a)
#pragma unroll
            for (int b = 0; b < 2; ++b)
#pragma unroll
                for (int m = 0; m < 4; ++m)
#pragma unroll
                    for (int n = 0; n < 2; ++n) acc[a][b][m][n] = (f32x4){0.f, 0.f, 0.f, 0.f};
        cur = nxt; cA = nA; cB = nB; ++ui;
        if constexpr (ALIGN_EPI) { if (wr == 1) PG8_BAR; }
    }
    PG8_WAIT_V(0);
    if constexpr (!ALIGN_EPI) { if (wr == 0) PG8_BAR; }
    PG8_BAR;
#undef PG8_SA
#undef PG8_SB
#undef PG8_STAGE
#undef PG8_LDA
#undef PG8_LDB
#undef PG8_MMA
#undef PG8_WAIT_V
#undef PG8_WAIT_L
#undef PG8_BAR
#undef PG8_SCHED
}
}
using pg8::cvt_pk_bf16;
using pg8::HALF;

__device__ __forceinline__ float bflo(unsigned w) { return __uint_as_float(w << 16); }
__device__ __forceinline__ float bfhi(unsigned w) { return __uint_as_float(w & 0xffff0000u); }
__device__ __forceinline__ float wave_sum(float v) {
#pragma unroll
    for (int o = 1; o < 64; o <<= 1) v += __shfl_xor(v, o);
    return v;
}
__device__ __forceinline__ float fast_sigmoid(float x) { return __builtin_amdgcn_rcpf(1.f + __builtin_amdgcn_exp2f(-1.4426950408889634f * x)); }
__device__ __forceinline__ float gelu_tanh(float v) { const float u = v + 0.044715f * v * v * v; return v * __builtin_amdgcn_rcpf(1.f + __builtin_amdgcn_exp2f(-2.302208198f * u)); }

template <int ACT>
__device__ __forceinline__ void store_perm(const f32x4 (&acc)[2][2][4][2], bf16_t* O, int ldc, int orow, int ocol, const float* rs, float inv_n, int grow, float cs) {
#pragma unroll
    for (int ai = 0; ai < 2; ++ai)
#pragma unroll
        for (int m = 0; m < 4; ++m) {
            const int ro = ai * HALF + m * 16;
            float s = cs;
            if (rs) { const float q = rs[grow + ro]; s *= (inv_n > 0.f) ? rsqrtf(q * inv_n + EPS) : q; }
            bf16_t* rowp = O + (size_t)(orow + ro) * ldc + ocol;
#pragma unroll
            for (int bj = 0; bj < 2; ++bj) {
                f32x4 v0 = acc[ai][bj][m][0] * s, v1 = acc[ai][bj][m][1] * s;
                if (ACT == 1) {
#pragma unroll
                    for (int j = 0; j < 4; ++j) { v0[j] = gelu_tanh(v0[j]); v1[j] = gelu_tanh(v1[j]); } }
                if (ACT == 2) {
#pragma unroll
                    for (int j = 0; j < 4; ++j) { const float a = fmaxf(v0[j], 0.f), b = fmaxf(v1[j], 0.f); v0[j] = a * a; v1[j] = b * b; } }
                u32x4 w; w.x = cvt_pk_bf16(v0[0], v0[1]); w.y = cvt_pk_bf16(v0[2], v0[3]); w.z = cvt_pk_bf16(v1[0], v1[1]); w.w = cvt_pk_bf16(v1[2], v1[3]);
                *(u32x4*)(rowp + bj * HALF) = w;
            }
        }
}
template <int ACT> struct EpiStd {
    static constexpr bool PERM = true;
    bf16_t* O; int ldc; const float* rs; float inv_n; float cs;
    __device__ __forceinline__ void operator()(const f32x4 (&acc)[2][2][4][2], const pg8::Unit& u, int wr, int wc, int fr, int fq) const {
        const int grow = u.pm * 256 + wr * 64 + fr;
        store_perm<ACT>(acc, O, ldc, grow, u.pn * 256 + wc * 32 + 8 * fq, rs, inv_n, grow, cs);
    }
};
struct EpiA1 {
    static constexpr bool PERM = true;
    bf16_t *xbr, *gg, *qm; const float* rs;
    __device__ __forceinline__ void operator()(const f32x4 (&acc)[2][2][4][2], const pg8::Unit& u, int wr, int wc, int fr, int fq) const {
        const int grow = u.pm * 256 + wr * 64 + fr, cl = wc * 32 + 8 * fq;
        if (u.pn < 6) store_perm<0>(acc, xbr, 1536, grow, u.pn * 256 + cl, rs, 0.f, grow, 1.f);
        else if (u.pn < 12) store_perm<1>(acc, gg, 1536, grow, (u.pn - 6) * 256 + cl, rs, 0.f, grow, 1.f);
        else store_perm<0>(acc, qm, 512, grow, (u.pn - 12) * 256 + cl, rs, 0.f, grow, MEMSCALE);
    }
};
struct EpiGate {
    static constexpr bool PERM = false;
    const bf16_t* xc; const float *br, *bi; unsigned* RU;
    __device__ __forceinline__ void operator()(const f32x4 (&acc)[2][2][4][2], const pg8::Unit& u, int wr, int wc, int fr, int fq) const {
        const int blk = 2 * u.g + u.pn, row0 = u.pm * 256 + wr * 64 + fr, chb = blk * 128 + wc * 32 + 4 * fq;
#pragma unroll
        for (int ai = 0; ai < 2; ++ai)
#pragma unroll
            for (int m = 0; m < 4; ++m) {
#pragma unroll
                for (int n = 0; n < 2; ++n) {
                    const int ch = chb + 16 * n;
                    const size_t off = (size_t)(row0 + ai * HALF + m * 16) * 1536 + ch;
                    const u32x2 xw = *(const u32x2*)(xc + off);
                    const f32x4 ar = acc[ai][0][m][n] + *(const f32x4*)(br + ch), aiv = acc[ai][1][m][n] + *(const f32x4*)(bi + ch);
                    u32x4 w;
                    w.x = cvt_pk_bf16(fast_sigmoid(ar[0]), fast_sigmoid(aiv[0]) * bflo(xw.x));
                    w.y = cvt_pk_bf16(fast_sigmoid(ar[1]), fast_sigmoid(aiv[1]) * bfhi(xw.x));
                    w.z = cvt_pk_bf16(fast_sigmoid(ar[2]), fast_sigmoid(aiv[2]) * bflo(xw.y));
                    w.w = cvt_pk_bf16(fast_sigmoid(ar[3]), fast_sigmoid(aiv[3]) * bfhi(xw.y));
                    *(u32x4*)(RU + off) = w;
                }
                asm volatile("" ::: "memory");
            }
    }
};
__device__ __forceinline__ void st4bf(bf16_t* p, f32x4 v) { u32x2 w; w.x = cvt_pk_bf16(v[0], v[1]); w.y = cvt_pk_bf16(v[2], v[3]); *(u32x2*)p = w; }
struct EpiB1 {
    static constexpr bool PERM = false;
    bf16_t *cq, *qm, *ckv, *kpe; float *ssq_cq, *ssq_lat; const float *rs, *cosT, *sinT;
    __device__ __forceinline__ void operator()(const f32x4 (&acc)[2][2][4][2], const pg8::Unit& u, int wr, int wc, int fr, int fq) const {
        const int row0 = u.pm * 256 + wr * 64 + fr, pn = u.pn;
        if (pn == 7) {
            if (wc < 2) {
                const int j = 16 * wc + 4 * fq;
#pragma unroll
                for (int ai = 0; ai < 2; ++ai)
#pragma unroll
                    for (int m = 0; m < 4; ++m) {
                        const int row = row0 + ai * HALF + m * 16; const float s = rsqrtf(rs[row] * (1.f / DM) + EPS);
                        const f32x4 c4 = *(const f32x4*)(cosT + (size_t)row * 32 + j), s4 = *(const f32x4*)(sinT + (size_t)row * 32 + j);
                        const f32x4 x1 = acc[ai][0][m][0] * s, x2 = acc[ai][0][m][1] * s;
                        st4bf(kpe + (size_t)row * 64 + j, x1 * c4 - x2 * s4); st4bf(kpe + (size_t)row * 64 + j + 32, x2 * c4 + x1 * s4);
                    }
            }
            return;
        }
        bf16_t* O; int ldc, ocol; float cs; float* ssq;
        if (pn < 3) { O = cq; ldc = 768; ocol = pn * 256; cs = 1.f; ssq = ssq_cq; }
        else if (pn < 5) { O = qm; ldc = 512; ocol = (pn - 3) * 256; cs = MEMSCALE; ssq = nullptr; }
        else { O = ckv; ldc = 512; ocol = (pn - 5) * 256; cs = 1.f; ssq = ssq_lat; }
        ocol += wc * 32 + 4 * fq;
#pragma unroll
        for (int ai = 0; ai < 2; ++ai)
#pragma unroll
            for (int m = 0; m < 4; ++m) {
                const int row = row0 + ai * HALF + m * 16; const float s = rsqrtf(rs[row] * (1.f / DM) + EPS) * cs; float part = 0.f;
#pragma unroll
                for (int bj = 0; bj < 2; ++bj)
#pragma unroll
                    for (int n = 0; n < 2; ++n) { const f32x4 v = acc[ai][bj][m][n] * s; part += (v[0] * v[0] + v[1] * v[1]) + (v[2] * v[2] + v[3] * v[3]);
                        st4bf(O + (size_t)row * ldc + ocol + bj * HALF + 16 * n, v); }
                if (ssq) { part += __shfl_xor(part, 16); part += __shfl_xor(part, 32); if (fq == 0) atomicAdd(ssq + row, part); }
            }
    }
};
struct EpiQ {
    static constexpr bool PERM = false;
    bf16_t* Q; const float *ssq, *cosT, *sinT;
    __device__ __forceinline__ void operator()(const f32x4 (&acc)[2][2][4][2], const pg8::Unit& u, int wr, int wc, int fr, int fq) const {
        const int row0 = u.pm * 256 + wr * 64 + fr;
#pragma unroll
        for (int ai = 0; ai < 2; ++ai)
#pragma unroll
            for (int m = 0; m < 4; ++m) {
                const int row = row0 + ai * HALF + m * 16; const float s = rsqrtf(ssq[row] * (1.f / 768.f) + EPS) * QSCALE;
#pragma unroll
                for (int bj = 0; bj < 2; ++bj) {
                    const int g64 = 4 * u.pn + 2 * bj + (wc >> 1), head = g64 / 3, part = g64 - head * 3;
                    if (part < 2) {
#pragma unroll
                        for (int n = 0; n < 2; ++n) st4bf(Q + (size_t)row * 2304 + u.pn * 256 + bj * HALF + wc * 32 + 16 * n + 4 * fq, acc[ai][bj][m][n] * s);
                    } else {
                        const int j = 16 * (wc & 1) + 4 * fq;
                        const f32x4 c4 = *(const f32x4*)(cosT + (size_t)row * 32 + j), s4 = *(const f32x4*)(sinT + (size_t)row * 32 + j);
                        const f32x4 x1 = acc[ai][bj][m][0] * s, x2 = acc[ai][bj][m][1] * s;
                        bf16_t* qp = Q + (size_t)row * 2304 + head * 192 + 128 + j;
                        st4bf(qp, x1 * c4 - x2 * s4); st4bf(qp + 32, x2 * c4 + x1 * s4);
                    }
                }
            }
    }
};

template <bool BASE_F32, bool OUT_F32> struct EpiNorm {
    static constexpr bool PERM = true;
    const float* baseF; bf16_t* HBio; float* outF; const float* g; float* ssqY; float* ssqH; unsigned* cnt; int row_off; LAS float* P;
    __device__ __forceinline__ void operator()(const f32x4 (&acc)[2][2][4][2], const pg8::Unit& u, int wr, int wc, int fr_, int fq_) const {
        int fr = fr_, fq = fq_; asm volatile("" : "+v"(fr), "+v"(fq));
        const int tid = (wr * 4 + wc) * 64 + fq * 16 + fr;
        const int prow = row_off + u.pm * 256;
        const int lrow = wr * 64 + fr, col0 = u.pn * 256 + wc * 32 + 8 * fq;
        u32x4 bw[2][2];
        if (!BASE_F32) {
#pragma unroll
            for (int i = 0; i < 2; ++i)
#pragma unroll
                for (int bj = 0; bj < 2; ++bj) bw[i][bj] = *(const u32x4*)(HBio + (size_t)(prow + lrow + i * 16) * DM + col0 + bj * HALF);
        }
#pragma unroll
        for (int ai = 0; ai < 2; ++ai)
#pragma unroll
            for (int m = 0; m < 4; ++m) { float p = 0.f;
#pragma unroll
                for (int bj = 0; bj < 2; ++bj)
#pragma unroll
                    for (int n = 0; n < 2; ++n) { const f32x4 v = acc[ai][bj][m][n]; p += (v[0] * v[0] + v[1] * v[1]) + (v[2] * v[2] + v[3] * v[3]); }
                p += __shfl_xor(p, 16); p += __shfl_xor(p, 32);
                if (fq == 0) P[(ai * HALF + wr * 64 + m * 16 + fr) * 4 + wc] = p; }
        asm volatile("s_waitcnt lgkmcnt(0)" ::: "memory"); __builtin_amdgcn_s_barrier(); asm volatile("" ::: "memory");
        if (tid < 256) { const float s = (P[tid * 4 + 0] + P[tid * 4 + 1]) + (P[tid * 4 + 2] + P[tid * 4 + 3]);
            (void)__hip_atomic_fetch_add(ssqY + prow + tid, s, __ATOMIC_RELAXED, __HIP_MEMORY_SCOPE_AGENT); }
        asm volatile("s_waitcnt vmcnt(0) lgkmcnt(0)" ::: "memory"); __builtin_amdgcn_s_barrier(); asm volatile("" ::: "memory");
        if (tid == 0) { unsigned* c = cnt + 64 * ((row_off >> 8) + u.pm);
            (void)__hip_atomic_fetch_add(c, 1u, __ATOMIC_RELEASE, __HIP_MEMORY_SCOPE_AGENT);
            unsigned sp = 0; while (__hip_atomic_load(c, __ATOMIC_RELAXED, __HIP_MEMORY_SCOPE_AGENT) < 8u) { __builtin_amdgcn_s_sleep(1); if (++sp > (1u << 22)) break; }
            __builtin_amdgcn_fence(__ATOMIC_ACQUIRE, "agent");
            asm volatile("s_waitcnt vmcnt(0)" ::: "memory"); }
        __builtin_amdgcn_s_barrier(); asm volatile("" ::: "memory");
        float ry[8];
#pragma unroll
        for (int i = 0; i < 8; ++i) ry[i] = __hip_atomic_load(ssqY + prow + lrow + (i >> 2) * HALF + (i & 3) * 16, __ATOMIC_RELAXED, __HIP_MEMORY_SCOPE_AGENT);
        f32x4 gv[2][2];
#pragma unroll
        for (int bj = 0; bj < 2; ++bj) { gv[bj][0] = *(const f32x4*)(g + col0 + bj * HALF); gv[bj][1] = *(const f32x4*)(g + col0 + bj * HALF + 4); }
        asm volatile("s_waitcnt vmcnt(0)" ::: "memory");
#pragma unroll
        for (int i = 0; i < 8; ++i) ry[i] = rsqrtf(ry[i] * (1.f / DM) + EPS);
#pragma unroll
        for (int ai = 0; ai < 2; ++ai)
#pragma unroll
            for (int m = 0; m < 4; ++m) { const float r = ry[ai * 4 + m]; const size_t rowoff = (size_t)(prow + lrow + ai * HALF + m * 16) * DM + col0; float p2 = 0.f;
#pragma unroll
                for (int bj = 0; bj < 2; ++bj) { const size_t off = rowoff + bj * HALF;
                    f32x4 b0, b1;
                    if (BASE_F32) { b0 = *(const f32x4*)(baseF + off); b1 = *(const f32x4*)(baseF + off + 4); }
                    else { u32x4 w; if (m < 2) { w = bw[m][bj]; if (ai == 0) bw[m][bj] = *(const u32x4*)(HBio + off + (size_t)HALF * DM); } else w = *(const u32x4*)(HBio + off); b0 = (f32x4){bflo(w.x), bfhi(w.x), bflo(w.y), bfhi(w.y)}; b1 = (f32x4){bflo(w.z), bfhi(w.z), bflo(w.w), bfhi(w.w)}; }
                    const f32x4 h0 = b0 + acc[ai][bj][m][0] * r * gv[bj][0], h1 = b1 + acc[ai][bj][m][1] * r * gv[bj][1];
                    if (OUT_F32) { __builtin_nontemporal_store(h0, (f32x4*)(outF + off)); __builtin_nontemporal_store(h1, (f32x4*)(outF + off + 4)); }
                    else { p2 += (h0[0] * h0[0] + h0[1] * h0[1]) + (h0[2] * h0[2] + h0[3] * h0[3]) + (h1[0] * h1[0] + h1[1] * h1[1]) + (h1[2] * h1[2] + h1[3] * h1[3]);
                        u32x4 o; o.x = cvt_pk_bf16(h0[0], h0[1]); o.y = cvt_pk_bf16(h0[2], h0[3]); o.z = cvt_pk_bf16(h1[0], h1[1]); o.w = cvt_pk_bf16(h1[2], h1[3]); *(u32x4*)(HBio + off) = o; } }
                if (!OUT_F32) { p2 += __shfl_xor(p2, 16); p2 += __shfl_xor(p2, 32); if (fq == 0) P[(ai * HALF + wr * 64 + m * 16 + fr) * 4 + wc] = p2; }
                asm volatile("" ::: "memory"); }
        asm volatile("s_waitcnt lgkmcnt(0)" ::: "memory"); __builtin_amdgcn_s_barrier(); asm volatile("" ::: "memory");
        if (!OUT_F32) { if (tid < 256) { const float s = (P[tid * 4 + 0] + P[tid * 4 + 1]) + (P[tid * 4 + 2] + P[tid * 4 + 3]);
            (void)__hip_atomic_fetch_add(ssqH + prow + tid, s, __ATOMIC_RELAXED, __HIP_MEMORY_SCOPE_AGENT); } }
    }
};

constexpr int SHM_V = 16384, SHM_K = 24576, ATT_SCR = 2 * SHM_V + 2 * SHM_K;
__device__ __forceinline__ int v_st(int k, int c) { const int kk = (k & ~0xC) | ((k & 4) << 1) | ((k & 8) >> 1); return ((kk >> 3) * 4 + (c >> 5)) * 512 + ((kk & 7) * 32 + (c & 31)) * 2; }
__device__ __forceinline__ int v_rd_base(int lane) { return ((lane & 3) << 3) | (((lane >> 2) & 3) << 6) | (((lane >> 4) & 1) << 5) | (((lane >> 5) & 1) << 8); }
__device__ __forceinline__ int crow(int r, int hi) { return (r & 3) + 8 * (r >> 2) + 4 * hi; }
#define SBAR() __builtin_amdgcn_sched_barrier(0)

struct AttnArgs { const bf16_t* Q; int ldq; const bf16_t* Kn; int ldk; const bf16_t* Kp; const bf16_t* V; int ldv; bf16_t* O; int ldo; int ntiles; int cb; };

__device__ __forceinline__ void att_partialSM(f32x16& p0, f32x16& p1, float& m_reg, float& alpha) {
    float pmax = p0[0];
#pragma unroll
    for (int r = 1; r < 16; ++r) pmax = fmaxf(pmax, p0[r]);
#pragma unroll
    for (int r = 0; r < 16; ++r) pmax = fmaxf(pmax, p1[r]);
    { auto rr = __builtin_amdgcn_permlane32_swap(__float_as_uint(pmax), __float_as_uint(pmax), false, false);
      pmax = fmaxf(__uint_as_float(rr[0]), __uint_as_float(rr[1])); }
    float mn;
    if (__all((pmax - m_reg) <= 11.f)) { mn = m_reg; alpha = 1.f; }
    else { mn = fmaxf(m_reg, pmax); alpha = __builtin_amdgcn_exp2f(m_reg - mn); m_reg = mn; }
#pragma unroll
    for (int r = 0; r < 16; ++r) { p0[r] = __builtin_amdgcn_exp2f(p0[r] - mn); p1[r] = __builtin_amdgcn_exp2f(p1[r] - mn); }
}
__device__ __forceinline__ void att_finishSM(const f32x16& p0, const f32x16& p1, float alpha, float& l_reg, bf16x8& pa0, bf16x8& pa1, bf16x8& pa2, bf16x8& pa3) {
    float ps = 0.f;
#pragma unroll
    for (int r = 0; r < 16; ++r) ps += p0[r] + p1[r];
    { auto rr = __builtin_amdgcn_permlane32_swap(__float_as_uint(ps), __float_as_uint(ps), false, false);
      ps = __uint_as_float(rr[0]) + __uint_as_float(rr[1]); }
    l_reg = l_reg * alpha + ps;
#define PK4(P, B_, OUT) do { unsigned a0 = cvt_pk_bf16(P[B_+0], P[B_+1]), a1 = cvt_pk_bf16(P[B_+2], P[B_+3]);                          \
        unsigned b0 = cvt_pk_bf16(P[B_+4], P[B_+5]), b1 = cvt_pk_bf16(P[B_+6], P[B_+7]);                                             \
        auto r0 = __builtin_amdgcn_permlane32_swap(a0, b0, false, false); auto r1 = __builtin_amdgcn_permlane32_swap(a1, b1, false, false); \
        u32x4 w = {r0[0], r1[0], r0[1], r1[1]}; OUT = *reinterpret_cast<bf16x8*>(&w); } while (0)
    PK4(p0, 0, pa0); PK4(p0, 8, pa1); PK4(p1, 0, pa2); PK4(p1, 8, pa3);
#undef PK4
}
template <int KB, int NKC>
__device__ __forceinline__ void att_qkt(f32x16& p0, f32x16& p1, const char* K_lds, int r32, int hi, const bf16x8* qr) {
    p0 = f32x16{}; p1 = f32x16{};
    const int x = (r32 >> 1) & 7;
    const char* kb[4];
#pragma unroll
    for (int dd = 0; dd < 4; ++dd) kb[dd] = K_lds + KB * SHM_K + r32 * 128 + (((dd * 2 + hi) ^ x) << 4);
#pragma unroll
    for (int d0 = 0; d0 < NKC; ++d0) { const char* a = kb[d0 & 3] + (d0 >> 2) * 8192;
        const bf16x8 b0 = *reinterpret_cast<const bf16x8*>(a);
        const bf16x8 b1 = *reinterpret_cast<const bf16x8*>(a + 4096);
        p0 = __builtin_amdgcn_mfma_f32_32x32x16_bf16(b0, qr[d0], p0, 0, 0, 0);
        p1 = __builtin_amdgcn_mfma_f32_32x32x16_bf16(b1, qr[d0], p1, 0, 0, 0); }
}
template <int VB>
__device__ __forceinline__ void att_pv(f32x16* o, int vb0, bf16x8 pa0, bf16x8 pa1, bf16x8 pa2, bf16x8 pa3) {
#define TRRD(dst, off) asm volatile("ds_read_b64_tr_b16 %0, %1 offset:%2" : "=&v"(dst) : "v"(vb0), "i"(off) : "memory")
#define PV_D0(d0) do { s16x4 l0, l1, l2, l3, h0, h1, h2, h3; constexpr int b_ = VB * SHM_V + (d0) * 512; \
        TRRD(l0, b_); TRRD(h0, b_ + 2048); TRRD(l1, b_ + 4096); TRRD(h1, b_ + 6144); TRRD(l2, b_ + 8192); TRRD(h2, b_ + 10240); TRRD(l3, b_ + 12288); TRRD(h3, b_ + 14336); \
        asm volatile("s_waitcnt lgkmcnt(0)" ::: "memory"); SBAR(); \
        o[d0] = __builtin_amdgcn_mfma_f32_32x32x16_bf16(pa0, (bf16x8){l0[0], l0[1], l0[2], l0[3], h0[0], h0[1], h0[2], h0[3]}, o[d0], 0, 0, 0);   \
        o[d0] = __builtin_amdgcn_mfma_f32_32x32x16_bf16(pa1, (bf16x8){l1[0], l1[1], l1[2], l1[3], h1[0], h1[1], h1[2], h1[3]}, o[d0], 0, 0, 0);   \
        o[d0] = __builtin_amdgcn_mfma_f32_32x32x16_bf16(pa2, (bf16x8){l2[0], l2[1], l2[2], l2[3], h2[0], h2[1], h2[2], h2[3]}, o[d0], 0, 0, 0);   \
        o[d0] = __builtin_amdgcn_mfma_f32_32x32x16_bf16(pa3, (bf16x8){l3[0], l3[1], l3[2], l3[3], h3[0], h3[1], h3[2], h3[3]}, o[d0], 0, 0, 0); } while (0)
    PV_D0(0); PV_D0(1); PV_D0(2); PV_D0(3);
#undef PV_D0
#undef TRRD
}

template <int NKC>
__device__ __forceinline__ void attn_unit(const AttnArgs& a, char* lds) {
    constexpr bool PE = NKC > 8;
    int tid_ = threadIdx.x; asm volatile("" : "+v"(tid_));
    const int tid = tid_, wid = __builtin_amdgcn_readfirstlane(tid >> 6), lane = tid & 63, r32 = lane & 31, hi = lane >> 5;
    char* V_lds = lds; char* K_lds = lds + 2 * SHM_V;
    float* wsf = (float*)(lds + ATT_SCR) + wid * 64; float* li_l = wsf; float* al_l = wsf + 32;
    const int sr = tid >> 4, c16 = tid & 15, sc = c16 * 8;
    const int vst0 = v_st(sr, sc), vst1 = v_st(32 + sr, sc);
    const int kws = (c16 >> 3) * 8192 + sr * 128 + (((c16 & 7) ^ ((sr >> 1) & 7)) << 4);
    const int pkey = tid >> 3, pws = 16384 + pkey * 128 + (((tid & 7) ^ ((pkey >> 1) & 7)) << 4);
    const int vb0 = (int)(uintptr_t)V_lds + v_rd_base(lane);
    const int mytiles = min(a.ntiles, a.cb + (wid >> 1) + 1);
    bf16x8 qr[NKC];
#pragma unroll
    for (int d0 = 0; d0 < NKC; ++d0) qr[d0] = __builtin_nontemporal_load((const bf16x8*)(a.Q + (size_t)(wid * 32 + r32) * a.ldq + d0 * 16 + hi * 8));
    bf16x8 st_k0, st_k1, st_v0, st_v1, st_p;
#define ALOAD(t) do { const size_t k0_ = (size_t)(t) * 64; \
        st_k0 = *(const bf16x8*)(a.Kn + (k0_ + sr) * a.ldk + sc); st_k1 = *(const bf16x8*)(a.Kn + (k0_ + 32 + sr) * a.ldk + sc); \
        st_v0 = *(const bf16x8*)(a.V + (k0_ + sr) * a.ldv + sc); st_v1 = *(const bf16x8*)(a.V + (k0_ + 32 + sr) * a.ldv + sc); \
        if constexpr (PE) st_p = *(const bf16x8*)(a.Kp + (k0_ + pkey) * 64 + (tid & 7) * 8); } while (0)
#define AWRITE(bf) do { *(bf16x8*)(K_lds + (bf) * SHM_K + kws) = st_k0; *(bf16x8*)(K_lds + (bf) * SHM_K + kws + 4096) = st_k1; \
        *(bf16x8*)(V_lds + (bf) * SHM_V + vst0) = st_v0; *(bf16x8*)(V_lds + (bf) * SHM_V + vst1) = st_v1; \
        if constexpr (PE) *(bf16x8*)(K_lds + (bf) * SHM_K + pws) = st_p; } while (0)
    float m_reg = -1e30f, l_reg = 0.f; f32x16 o[4] = {};
    ALOAD(0); AWRITE(0);
    __syncthreads();
#define ATILE(t, BF) do { \
        if ((t) + 1 < a.ntiles) ALOAD((t) + 1); \
        if ((t) < mytiles) { f32x16 p0, p1; float alpha; bf16x8 pa0, pa1, pa2, pa3; \
            att_qkt<BF, NKC>(p0, p1, K_lds, r32, hi, qr); \
            att_partialSM(p0, p1, m_reg, alpha); \
            if (__any(alpha < 1.f)) { if (hi == 0) al_l[r32] = alpha; asm volatile("s_waitcnt lgkmcnt(0)" ::: "memory"); \
                _Pragma("unroll") for (int d_ = 0; d_ < 4; ++d_) _Pragma("unroll") for (int r = 0; r < 16; ++r) o[d_][r] *= al_l[crow(r, hi)]; } \
            att_finishSM(p0, p1, alpha, l_reg, pa0, pa1, pa2, pa3); SBAR(); \
            att_pv<BF>(o, vb0, pa0, pa1, pa2, pa3); } \
        if ((t) + 1 < a.ntiles) AWRITE(1 - (BF)); \
        __syncthreads(); } while (0)
    for (int t = 0; t < a.ntiles; t += 2) {
        ATILE(t, 0);
        if (t + 1 < a.ntiles) ATILE(t + 1, 1);
    }
#undef ATILE
#undef ALOAD
#undef AWRITE
    if (hi == 0) li_l[r32] = l_reg; asm volatile("s_waitcnt lgkmcnt(0)" ::: "memory");
    float rli[16];
#pragma unroll
    for (int r = 0; r < 16; ++r) rli[r] = __builtin_amdgcn_rcpf(li_l[crow(r, hi)]);
    bf16_t* Ow = a.O + (size_t)(wid * 32) * a.ldo;
#pragma unroll
    for (int r = 0; r < 16; ++r) { const int orow = crow(r, hi);
#pragma unroll
        for (int d0 = 0; d0 < 4; ++d0) { const float v = o[d0][r] * rli[r];
            const float vn = __shfl_xor(v, 1);
            if ((r32 & 1) == 0) *(unsigned*)(Ow + (size_t)orow * a.ldo + d0 * 32 + r32) = cvt_pk_bf16(v, vn); } }
    __syncthreads();
}

#define XB_TMO      128
#define XB_XCNT(j)  (256  + 64 * (j))
#define XB_XSUB(j)  (1280 + 64 * (j))
#define XB_XGEN(j)  (2304 + 64 * (j))
#define XB_TOP      3328
#define XB_TOPGEN   3392
#define XCD_BAR_WORDS 3456
#define XB_SPIN_CAP (1u << 18)

__device__ __forceinline__ unsigned xb_ld(unsigned* p)              { return __hip_atomic_load(p, __ATOMIC_RELAXED, __HIP_MEMORY_SCOPE_AGENT); }
__device__ __forceinline__ unsigned xb_add(unsigned* p, unsigned v) { return __hip_atomic_fetch_add(p, v, __ATOMIC_RELAXED, __HIP_MEMORY_SCOPE_AGENT); }
__device__ __forceinline__ unsigned xb_xcc_id() { return (unsigned)__builtin_amdgcn_s_getreg((3 << 11) | 20) & 0xFu; }
#define XB_SPIN(cond, bar) do { unsigned _sp = 0; while (cond) { __builtin_amdgcn_s_sleep(1); \
    if ((++_sp & 255u) == 0u) { if (xb_ld(&(bar)[XB_TMO])) break; if (_sp > XB_SPIN_CAP) { atomicAdd(&(bar)[XB_TMO], 1u); break; } } } } while (0)

struct XcdBarrier {
    unsigned* bar; unsigned x;
    volatile LAS unsigned* st;
};

__device__ __forceinline__ XcdBarrier xcd_barrier_post(unsigned* bar, volatile LAS unsigned* st) {
    XcdBarrier b; b.bar = bar; b.x = xb_xcc_id(); b.st = st;
    if (threadIdx.x == 0) (void)xb_add(&bar[XB_XCNT(b.x)], 1u);
    return b;
}
__device__ __forceinline__ void xcd_barrier_complete(unsigned* bar, unsigned x, unsigned& nloc, unsigned& nx) {
    const unsigned G = gridDim.x * gridDim.y * gridDim.z;
    unsigned sum, cnt, mine, sp = 0u;
    for (;;) {
        sum = 0u; cnt = 0u; mine = 0u;
#pragma unroll
        for (unsigned j = 0; j < 16; ++j) { const unsigned c = xb_ld(&bar[XB_XCNT(j)]); sum += c; cnt += (c > 0u) ? 1u : 0u; mine = (j == x) ? c : mine; }
        if (sum == G) break;
        __builtin_amdgcn_s_sleep(1);
        if ((++sp & 255u) == 0u) { if (xb_ld(&bar[XB_TMO])) break; if (sp > XB_SPIN_CAP) { atomicAdd(&bar[XB_TMO], 1u); break; } }
    }
    nloc = mine > 0u ? mine : 1u; nx = cnt > 0u ? cnt : 1u;
}

__device__ __forceinline__ void xcd_barrier(const XcdBarrier& b) {
    asm volatile("s_waitcnt vmcnt(0)" ::: "memory");
    __syncthreads();
    if (threadIdx.x == 0) {
        unsigned* bar = b.bar;
        __builtin_amdgcn_s_waitcnt(0);
        unsigned nloc = b.st[0], nx = b.st[1];
        if (nloc == 0u) { xcd_barrier_complete(bar, b.x, nloc, nx); b.st[0] = nloc; b.st[1] = nx; }
        const unsigned old = xb_add(&bar[XB_XSUB(b.x)], 1u);
        const unsigned gen = old / nloc;
        if (old + 1u == (gen + 1u) * nloc) {
            __builtin_amdgcn_fence(__ATOMIC_RELEASE, "agent");
            asm volatile("s_waitcnt vmcnt(0)" ::: "memory");
            const unsigned og = xb_add(&bar[XB_TOP], 1u);
            const unsigned tg = og / nx;
            if (og + 1u == (tg + 1u) * nx) xb_add(&bar[XB_TOPGEN], 1u);
            else XB_SPIN(xb_ld(&bar[XB_TOPGEN]) == tg, bar);
            __builtin_amdgcn_fence(__ATOMIC_ACQUIRE, "agent");
            xb_add(&bar[XB_XGEN(b.x)], 1u);
            asm volatile("s_waitcnt vmcnt(0)" ::: "memory");
        } else {
            XB_SPIN(xb_ld(&bar[XB_XGEN(b.x)]) == gen, bar);
            __builtin_amdgcn_fence(__ATOMIC_ACQUIRE, "agent");
            asm volatile("s_waitcnt vmcnt(0)" ::: "memory");
        }
    }
    __syncthreads();
}

constexpr int ATT_SLOTS = 8;
__device__ const unsigned short g_att_sched[256][ATT_SLOTS] = {
{15,518,512,1056,1200,65535,65535,65535},
{31,534,528,1057,1201,65535,65535,65535},
{47,550,544,1058,1202,65535,65535,65535},
{63,566,560,1059,1203,65535,65535,65535},
{79,582,576,1060,1204,65535,65535,65535},
{95,598,592,1061,1205,65535,65535,65535},
{111,614,608,1062,1206,65535,65535,65535},
{127,630,624,1063,1207,65535,65535,65535},
{143,646,640,1064,1208,65535,65535,65535},
{159,662,656,1065,1209,65535,65535,65535},
{175,678,672,1066,1210,65535,65535,65535},
{191,694,688,1067,1211,65535,65535,65535},
{207,710,704,1068,1212,65535,65535,65535},
{223,726,720,1069,1213,65535,65535,65535},
{239,742,736,1070,1214,65535,65535,65535},
{255,758,752,1071,1215,65535,65535,65535},
{271,5,514,1152,65535,65535,65535,65535},
{287,21,530,1153,65535,65535,65535,65535},
{303,37,546,1154,65535,65535,65535,65535},
{319,53,562,1155,65535,65535,65535,65535},
{335,69,578,1156,65535,65535,65535,65535},
{351,85,594,1157,65535,65535,65535,65535},
{367,101,610,1158,65535,65535,65535,65535},
{383,117,626,1159,65535,65535,65535,65535},
{399,133,642,1160,65535,65535,65535,65535},
{415,149,658,1161,65535,65535,65535,65535},
{431,165,674,1162,65535,65535,65535,65535},
{447,181,690,1163,65535,65535,65535,65535},
{463,197,706,1164,65535,65535,65535,65535},
{479,213,722,1165,65535,65535,65535,65535},
{495,229,738,1166,65535,65535,65535,65535},
{511,245,754,1167,65535,65535,65535,65535},
{527,261,1,1072,1216,65535,65535,65535},
{543,277,17,1073,1217,65535,65535,65535},
{559,293,33,1074,1218,65535,65535,65535},
{575,309,49,1075,1219,65535,65535,65535},
{591,325,65,1076,1220,65535,65535,65535},
{607,341,81,1077,1221,65535,65535,65535},
{623,357,97,1078,1222,65535,65535,65535},
{639,373,113,1079,1223,65535,65535,65535},
{655,389,129,1080,1224,65535,65535,65535},
{671,405,145,1081,1225,65535,65535,65535},
{687,421,161,1082,1226,65535,65535,65535},
{703,437,177,1083,1227,65535,65535,65535},
{719,453,193,1084,1228,65535,65535,65535},
{735,469,209,1085,1229,65535,65535,65535},
{751,485,225,1086,1230,65535,65535,65535},
{767,501,241,1087,1231,65535,65535,65535},
{14,519,257,1088,65535,65535,65535,65535},
{30,535,273,1089,65535,65535,65535,65535},
{46,551,289,1090,65535,65535,65535,65535},
{62,567,305,1091,65535,65535,65535,65535},
{78,583,321,1092,65535,65535,65535,65535},
{94,599,337,1093,65535,65535,65535,65535},
{110,615,353,1094,65535,65535,65535,65535},
{126,631,369,1095,65535,65535,65535,65535},
{142,647,385,1096,65535,65535,65535,65535},
{158,663,401,1097,65535,65535,65535,65535},
{174,679,417,1098,65535,65535,65535,65535},
{190,695,433,1099,65535,65535,65535,65535},
{206,711,449,1100,65535,65535,65535,65535},
{222,727,465,1101,65535,65535,65535,65535},
{238,743,481,1102,65535,65535,65535,65535},
{254,759,497,1103,65535,65535,65535,65535},
{13,6,517,65535,65535,65535,65535,65535},
{29,22,533,65535,65535,65535,65535,65535},
{45,38,549,65535,65535,65535,65535,65535},
{61,54,565,65535,65535,65535,65535,65535},
{77,70,581,65535,65535,65535,65535,65535},
{93,86,597,65535,65535,65535,65535,65535},
{109,102,613,65535,65535,65535,65535,65535},
{125,118,629,65535,65535,65535,65535,65535},
{141,134,645,65535,65535,65535,65535,65535},
{157,150,661,65535,65535,65535,65535,65535},
{173,166,677,65535,65535,65535,65535,65535},
{189,182,693,65535,65535,65535,65535,65535},
{205,198,709,65535,65535,65535,65535,65535},
{221,214,725,65535,65535,65535,65535,65535},
{237,230,741,65535,65535,65535,65535,65535},
{253,246,757,65535,65535,65535,65535,65535},
{526,262,4,65535,65535,65535,65535,65535},
{542,278,20,65535,65535,65535,65535,65535},
{558,294,36,65535,65535,65535,65535,65535},
{574,310,52,65535,65535,65535,65535,65535},
{590,326,68,65535,65535,65535,65535,65535},
{606,342,84,65535,65535,65535,65535,65535},
{622,358,100,65535,65535,65535,65535,65535},
{638,374,116,65535,65535,65535,65535,65535},
{654,390,132,65535,65535,65535,65535,65535},
{670,406,148,65535,65535,65535,65535,65535},
{686,422,164,65535,65535,65535,65535,65535},
{702,438,180,65535,65535,65535,65535,65535},
{718,454,196,65535,65535,65535,65535,65535},
{734,470,212,65535,65535,65535,65535,65535},
{750,486,228,65535,65535,65535,65535,65535},
{766,502,244,65535,65535,65535,65535,65535},
{270,520,513,1104,65535,65535,65535,65535},
{286,536,529,1105,65535,65535,65535,65535},
{302,552,545,1106,65535,65535,65535,65535},
{318,568,561,1107,65535,65535,65535,65535},
{334,584,577,1108,65535,65535,65535,65535},
{350,600,593,1109,65535,65535,65535,65535},
{366,616,609,1110,65535,65535,65535,65535},
{382,632,625,1111,65535,65535,65535,65535},
{398,648,641,1112,65535,65535,65535,65535},
{414,664,657,1113,65535,65535,65535,65535},
{430,680,673,1114,65535,65535,65535,65535},
{446,696,689,1115,65535,65535,65535,65535},
{462,712,705,1116,65535,65535,65535,65535},
{478,728,721,1117,65535,65535,65535,65535},
{494,744,737,1118,65535,65535,65535,65535},
{510,760,753,1119,65535,65535,65535,65535},
{269,7,260,65535,65535,65535,65535,65535},
{285,23,276,65535,65535,65535,65535,65535},
{301,39,292,65535,65535,65535,65535,65535},
{317,55,308,65535,65535,65535,65535,65535},
{333,71,324,65535,65535,65535,65535,65535},
{349,87,340,65535,65535,65535,65535,65535},
{365,103,356,65535,65535,65535,65535,65535},
{381,119,372,65535,65535,65535,65535,65535},
{397,135,388,65535,65535,65535,65535,65535},
{413,151,404,65535,65535,65535,65535,65535},
{429,167,420,65535,65535,65535,65535,65535},
{445,183,436,65535,65535,65535,65535,65535},
{461,199,452,65535,65535,65535,65535,65535},
{477,215,468,65535,65535,65535,65535,65535},
{493,231,484,65535,65535,65535,65535,65535},
{509,247,500,65535,65535,65535,65535,65535},
{525,263,516,65535,65535,65535,65535,65535},
{541,279,532,65535,65535,65535,65535,65535},
{557,295,548,65535,65535,65535,65535,65535},
{573,311,564,65535,65535,65535,65535,65535},
{589,327,580,65535,65535,65535,65535,65535},
{605,343,596,65535,65535,65535,65535,65535},
{621,359,612,65535,65535,65535,65535,65535},
{637,375,628,65535,65535,65535,65535,65535},
{653,391,644,65535,65535,65535,65535,65535},
{669,407,660,65535,65535,65535,65535,65535},
{685,423,676,65535,65535,65535,65535,65535},
{701,439,692,65535,65535,65535,65535,65535},
{717,455,708,65535,65535,65535,65535,65535},
{733,471,724,65535,65535,65535,65535,65535},
{749,487,740,65535,65535,65535,65535,65535},
{765,503,756,65535,65535,65535,65535,65535},
{12,521,0,1024,1168,65535,65535,65535},
{28,537,16,1025,1169,65535,65535,65535},
{44,553,32,1026,1170,65535,65535,65535},
{60,569,48,1027,1171,65535,65535,65535},
{76,585,64,1028,1172,65535,65535,65535},
{92,601,80,1029,1173,65535,65535,65535},
{108,617,96,1030,1174,65535,65535,65535},
{124,633,112,1031,1175,65535,65535,65535},
{140,649,128,1032,1176,65535,65535,65535},
{156,665,144,1033,1177,65535,65535,65535},
{172,681,160,1034,1178,65535,65535,65535},
{188,697,176,1035,1179,65535,65535,65535},
{204,713,192,1036,1180,65535,65535,65535},
{220,729,208,1037,1181,65535,65535,65535},
{236,745,224,1038,1182,65535,65535,65535},
{252,761,240,1039,1183,65535,65535,65535},
{268,8,3,1232,65535,65535,65535,65535},
{284,24,19,1233,65535,65535,65535,65535},
{300,40,35,1234,65535,65535,65535,65535},
{316,56,51,1235,65535,65535,65535,65535},
{332,72,67,1236,65535,65535,65535,65535},
{348,88,83,1237,65535,65535,65535,65535},
{364,104,99,1238,65535,65535,65535,65535},
{380,120,115,1239,65535,65535,65535,65535},
{396,136,131,1240,65535,65535,65535,65535},
{412,152,147,1241,65535,65535,65535,65535},
{428,168,163,1242,65535,65535,65535,65535},
{444,184,179,1243,65535,65535,65535,65535},
{460,200,195,1244,65535,65535,65535,65535},
{476,216,211,1245,65535,65535,65535,65535},
{492,232,227,1246,65535,65535,65535,65535},
{508,248,243,1247,65535,65535,65535,65535},
{524,264,259,1248,65535,65535,65535,65535},
{540,280,275,1249,65535,65535,65535,65535},
{556,296,291,1250,65535,65535,65535,65535},
{572,312,307,1251,65535,65535,65535,65535},
{588,328,323,1252,65535,65535,65535,65535},
{604,344,339,1253,65535,65535,65535,65535},
{620,360,355,1254,65535,65535,65535,65535},
{636,376,371,1255,65535,65535,65535,65535},
{652,392,387,1256,65535,65535,65535,65535},
{668,408,403,1257,65535,65535,65535,65535},
{684,424,419,1258,65535,65535,65535,65535},
{700,440,435,1259,65535,65535,65535,65535},
{716,456,451,1260,65535,65535,65535,65535},
{732,472,467,1261,65535,65535,65535,65535},
{748,488,483,1262,65535,65535,65535,65535},
{764,504,499,1263,65535,65535,65535,65535},
{11,522,256,1040,1184,65535,65535,65535},
{27,538,272,1041,1185,65535,65535,65535},
{43,554,288,1042,1186,65535,65535,65535},
{59,570,304,1043,1187,65535,65535,65535},
{75,586,320,1044,1188,65535,65535,65535},
{91,602,336,1045,1189,65535,65535,65535},
{107,618,352,1046,1190,65535,65535,65535},
{123,634,368,1047,1191,65535,65535,65535},
{139,650,384,1048,1192,65535,65535,65535},
{155,666,400,1049,1193,65535,65535,65535},
{171,682,416,1050,1194,65535,65535,65535},
{187,698,432,1051,1195,65535,65535,65535},
{203,714,448,1052,1196,65535,65535,65535},
{219,730,464,1053,1197,65535,65535,65535},
{235,746,480,1054,1198,65535,65535,65535},
{251,762,496,1055,1199,65535,65535,65535},
{267,9,515,1264,65535,65535,65535,65535},
{283,25,531,1265,65535,65535,65535,65535},
{299,41,547,1266,65535,65535,65535,65535},
{315,57,563,1267,65535,65535,65535,65535},
{331,73,579,1268,65535,65535,65535,65535},
{347,89,595,1269,65535,65535,65535,65535},
{363,105,611,1270,65535,65535,65535,65535},
{379,121,627,1271,65535,65535,65535,65535},
{395,137,643,1272,65535,65535,65535,65535},
{411,153,659,1273,65535,65535,65535,65535},
{427,169,675,1274,65535,65535,65535,65535},
{443,185,691,1275,65535,65535,65535,65535},
{459,201,707,1276,65535,65535,65535,65535},
{475,217,723,1277,65535,65535,65535,65535},
{491,233,739,1278,65535,65535,65535,65535},
{507,249,755,1279,65535,65535,65535,65535},
{523,265,2,1120,65535,65535,65535,65535},
{539,281,18,1121,65535,65535,65535,65535},
{555,297,34,1122,65535,65535,65535,65535},
{571,313,50,1123,65535,65535,65535,65535},
{587,329,66,1124,65535,65535,65535,65535},
{603,345,82,1125,65535,65535,65535,65535},
{619,361,98,1126,65535,65535,65535,65535},
{635,377,114,1127,65535,65535,65535,65535},
{651,393,130,1128,65535,65535,65535,65535},
{667,409,146,1129,65535,65535,65535,65535},
{683,425,162,1130,65535,65535,65535,65535},
{699,441,178,1131,65535,65535,65535,65535},
{715,457,194,1132,65535,65535,65535,65535},
{731,473,210,1133,65535,65535,65535,65535},
{747,489,226,1134,65535,65535,65535,65535},
{763,505,242,1135,65535,65535,65535,65535},
{10,266,258,1136,65535,65535,65535,65535},
{26,282,274,1137,65535,65535,65535,65535},
{42,298,290,1138,65535,65535,65535,65535},
{58,314,306,1139,65535,65535,65535,65535},
{74,330,322,1140,65535,65535,65535,65535},
{90,346,338,1141,65535,65535,65535,65535},
{106,362,354,1142,65535,65535,65535,65535},
{122,378,370,1143,65535,65535,65535,65535},
{138,394,386,1144,65535,65535,65535,65535},
{154,410,402,1145,65535,65535,65535,65535},
{170,426,418,1146,65535,65535,65535,65535},
{186,442,434,1147,65535,65535,65535,65535},
{202,458,450,1148,65535,65535,65535,65535},
{218,474,466,1149,65535,65535,65535,65535},
{234,490,482,1150,65535,65535,65535,65535},
{250,506,498,1151,65535,65535,65535,65535}};

struct Args {
    const float *x, *mem; const int* pos;
    const float *g_mix_pre, *g_mix_post, *g_mlp_pre, *g_mlp_post, *g_mem, *w_mem_k, *w_mem_v, *w_o, *w_ff1, *w_ff2;
    const float *a_w_in, *a_conv_w, *a_conv_b, *a_w_r, *a_b_r, *a_w_i, *a_b_i, *a_lambda;
    const float *b_w_in, *b_g_qa, *b_w_qb, *kv_g_in, *kv_w_down, *kv_g_latent, *kv_w_up;
    float* out; unsigned char* ws;
    float invf[32];
    int ph_lo, ph_hi;
};

__device__ __forceinline__ int rope_pos(int j) { return 32 * ((j >> 4) & 1) + 16 * (j >> 5) + (j & 15); }
__device__ __forceinline__ void tr_load(const float* W, int ldw, int scol0, int ncols, int item, int lane, float (&v)[32]) {
    const int nblk = ncols / 32, kb = item / nblk, nb = item - kb * nblk, k0 = 64 * kb, n0 = 32 * nb;
    const float* wp = W + (size_t)(k0 + (lane >> 5)) * ldw + scol0 + n0 + (lane & 31);
#pragma unroll
    for (int i = 0; i < 32; ++i) v[i] = __builtin_nontemporal_load(wp + (size_t)(2 * i) * ldw);
}
__device__ __forceinline__ void tr_store(const float (&v)[32], int ncols, const float* gain, bf16_t* WT, int ldk, int koff, int kind, int rbase, LAS float* scr, int item, int lane, bool far = false) {
    const int nblk = ncols / 32, kb = item / nblk, nb = item - kb * nblk, k0 = 64 * kb, n0 = 32 * nb;
    const int c = lane & 7;
    f32x4 g0 = {1.f, 1.f, 1.f, 1.f}, g1 = g0;
    if (gain) { g0 = *(const f32x4*)(gain + k0 + 8 * c); g1 = *(const f32x4*)(gain + k0 + 8 * c + 4); }
#pragma unroll
    for (int i = 0; i < 32; ++i) scr[(2 * i + (lane >> 5)) * 33 + (lane & 31)] = v[i];
    asm volatile("s_waitcnt lgkmcnt(0)" ::: "memory");
#pragma unroll
    for (int j = 0; j < 4; ++j) { const int n = (lane >> 3) + 8 * j; const LAS float* s = scr + (8 * c) * 33 + n;
        u32x4 o; o.x = cvt_pk_bf16(s[0 * 33] * g0[0], s[1 * 33] * g0[1]); o.y = cvt_pk_bf16(s[2 * 33] * g0[2], s[3 * 33] * g0[3]);
        o.z = cvt_pk_bf16(s[4 * 33] * g1[0], s[5 * 33] * g1[1]); o.w = cvt_pk_bf16(s[6 * 33] * g1[2], s[7 * 33] * g1[3]);
        const int nn = n0 + n; int drow;
        if (kind == 0) drow = rbase + nn;
        else if (kind == 1) { const int head = nn / 192, w = nn - head * 192; drow = head * 192 + (w >= 128 ? 128 + rope_pos(w - 128) : w); }
        else drow = rbase + rope_pos(nn);
        if (far) __builtin_nontemporal_store(o, (u32x4*)(WT + (size_t)drow * ldk + koff + k0 + 8 * c)); else *(u32x4*)(WT + (size_t)drow * ldk + koff + k0 + 8 * c) = o; }
    asm volatile("s_waitcnt lgkmcnt(0)" ::: "memory");
}
__device__ __forceinline__ void tr_job(int& it, int stride, const float* W, int ldw, int scol0, int ncols, int K, const float* gain, bf16_t* WT, int ldk, int koff, int kind, int rbase, LAS float* scr, int lane, bool far = false) {
    const int ni = (K / 64) * (ncols / 32);
    if (it < ni) { float v[32]; tr_load(W, ldw, scol0, ncols, it, lane, v);
        for (;;) { const int nx = it + stride; float w[32];
            if (nx < ni) tr_load(W, ldw, scol0, ncols, nx, lane, w);
            tr_store(v, ncols, gain, WT, ldk, koff, kind, rbase, scr, it, lane, far);
            it = nx; if (nx >= ni) break;
#pragma unroll
            for (int i = 0; i < 32; ++i) v[i] = w[i]; } }
    it -= ni;
}
__device__ __forceinline__ void cvt_rows(const float* src, bf16_t* dst, float* rstd, int nrows, int gw, int NGW, int lane) {
    for (int row = gw; row < nrows; row += NGW) {
        const float* xr = src + (size_t)row * DM; float ss = 0.f;
#pragma unroll
        for (int j = 0; j < 4; ++j) { const int col = (lane + 64 * j) * 8; const f32x4 a = *(const f32x4*)(xr + col), b = *(const f32x4*)(xr + col + 4);
            ss += (a[0] * a[0] + a[1] * a[1]) + (a[2] * a[2] + a[3] * a[3]) + (b[0] * b[0] + b[1] * b[1]) + (b[2] * b[2] + b[3] * b[3]);
            u32x4 w; w.x = cvt_pk_bf16(a[0], a[1]); w.y = cvt_pk_bf16(a[2], a[3]); w.z = cvt_pk_bf16(b[0], b[1]); w.w = cvt_pk_bf16(b[2], b[3]);
            *(u32x4*)(dst + (size_t)row * DM + col) = w; }
        ss = wave_sum(ss);
        if (lane == 0) rstd[row] = rsqrtf(ss * (1.f / DM) + EPS);
    }
}
template <bool BASE_F32, bool OUT_F32>
__device__ __forceinline__ void row_pass(const bf16_t* Y, const float* baseF, const float* g, float* outF, bf16_t* HBio, float* rstd_out, int gw, int NGW, int lane) {
    for (int row = gw; row < T; row += NGW) {
        const u32x4* yr = (const u32x4*)(Y + (size_t)row * DM) + lane;
        u32x4 yw[4]; u32x4 bw[4]; float ss = 0.f;
#pragma unroll
        for (int j = 0; j < 4; ++j) yw[j] = yr[64 * j];
        if (!BASE_F32) {
#pragma unroll
            for (int j = 0; j < 4; ++j) bw[j] = ((const u32x4*)(HBio + (size_t)row * DM) + lane)[64 * j]; }
#pragma unroll
        for (int j = 0; j < 4; ++j) { const u32x4 w = yw[j];
            ss += bflo(w.x) * bflo(w.x) + bfhi(w.x) * bfhi(w.x) + bflo(w.y) * bflo(w.y) + bfhi(w.y) * bfhi(w.y) + bflo(w.z) * bflo(w.z) + bfhi(w.z) * bfhi(w.z) + bflo(w.w) * bflo(w.w) + bfhi(w.w) * bfhi(w.w); }
        ss = wave_sum(ss);
        const float ry = rsqrtf(ss * (1.f / DM) + EPS); float ss2 = 0.f;
#pragma unroll
        for (int j = 0; j < 4; ++j) { const int col = (lane + 64 * j) * 8; const size_t off = (size_t)row * DM + col;
            f32x4 b0, b1;
            if (BASE_F32) { b0 = *(const f32x4*)(baseF + off); b1 = *(const f32x4*)(baseF + off + 4); }
            else { const u32x4 w = bw[j]; b0 = (f32x4){bflo(w.x), bfhi(w.x), bflo(w.y), bfhi(w.y)}; b1 = (f32x4){bflo(w.z), bfhi(w.z), bflo(w.w), bfhi(w.w)}; }
            const f32x4 g0 = *(const f32x4*)(g + col), g1 = *(const f32x4*)(g + col + 4);
            const u32x4 w = yw[j];
            const f32x4 y0 = {bflo(w.x), bfhi(w.x), bflo(w.y), bfhi(w.y)}, y1 = {bflo(w.z), bfhi(w.z), bflo(w.w), bfhi(w.w)};
            const f32x4 h0 = b0 + y0 * ry * g0, h1 = b1 + y1 * ry * g1;
            if (OUT_F32) { *(f32x4*)(outF + off) = h0; *(f32x4*)(outF + off + 4) = h1; }
            else { ss2 += (h0[0] * h0[0] + h0[1] * h0[1]) + (h0[2] * h0[2] + h0[3] * h0[3]) + (h1[0] * h1[0] + h1[1] * h1[1]) + (h1[2] * h1[2] + h1[3] * h1[3]);
                u32x4 o; o.x = cvt_pk_bf16(h0[0], h0[1]); o.y = cvt_pk_bf16(h0[2], h0[3]); o.z = cvt_pk_bf16(h1[0], h1[1]); o.w = cvt_pk_bf16(h1[2], h1[3]); *(u32x4*)(HBio + off) = o; } }
        if (!OUT_F32) { ss2 = wave_sum(ss2); if (lane == 0) rstd_out[row] = rsqrtf(ss2 * (1.f / DM) + EPS); }
    }
}

constexpr int LDS_BYTES = 147456;
constexpr int NPH = 21;

#ifndef PHMASK
#define PHMASK 0xffffffffu
#endif
typedef const __attribute__((address_space(4))) Args* ArgsP;
#define PHASE_BEGIN ArgsP ap = (ArgsP)__builtin_amdgcn_kernarg_segment_ptr(); asm volatile("" : "+s"(ap) :: "memory"); unsigned char* ws = ap->ws; \
    int tid_ = threadIdx.x, bx_ = blockIdx.x; asm volatile("" : "+v"(tid_), "+s"(bx_)); const int tid = tid_, lane = tid & 63, wave = __builtin_amdgcn_readfirstlane(tid >> 6); const int G = gridDim.x, bx = bx_; \
    const int gw = bx * 8 + wave, NGW = G * 8, gt = bx * 512 + tid, NGT = G * 512; (void)lane; (void)gw; (void)NGW; (void)gt; (void)NGT; (void)ws;
using SO = pg8::StaticOrder;
using EN_TF = EpiNorm<true, false>; using EN_FF = EpiNorm<false, false>; using EN_FT = EpiNorm<false, true>;
#define RUN_GEMM(EPI, e, A_, B_, lda_, ldb_, K_, M_, N_, cidx) do { pg8::Gemm g_{A_, B_, lda_, ldb_, K_, 0, 0}; SO S_; S_.init(M_, N_, G, cidx); \
        pg8::gemm_phase<EPI, SO, true, true>(ldsl, g_, S_, e); } while (0)
#define WSP(T_, off) ((T_*)(ws + (off)))

__global__ void __launch_bounds__(512, 2) fwd_mega(Args args_unused) {
    extern __shared__ __attribute__((aligned(16))) unsigned char lds[];
    LAS unsigned char* ldsl = (LAS unsigned char*)lds;
    volatile LAS unsigned* bst = (volatile LAS unsigned*)(ldsl + 131072 + 64);
    if (threadIdx.x < 4) bst[threadIdx.x] = 0u;
    __syncthreads();
    { ArgsP ap0 = (ArgsP)__builtin_amdgcn_kernarg_segment_ptr(); (void)xcd_barrier_post((unsigned*)(ap0->ws + WS_BAR), bst); }
#define SEAM() do { ArgsP apb_ = (ArgsP)__builtin_amdgcn_kernarg_segment_ptr(); asm volatile("" : "+s"(apb_) :: "memory"); XcdBarrier b_; b_.bar = (unsigned*)(apb_->ws + WS_BAR); b_.x = xb_xcc_id(); b_.st = bst; xcd_barrier(b_); } while (0)

    if ((PHMASK >> 0) & 1) { PHASE_BEGIN
        float* ssq_cq = WSP(float, WS_SSQCQ); float* ssq_lat = WSP(float, WS_SSQLAT); float* cosT = WSP(float, WS_COS); float* sinT = WSP(float, WS_SIN);
        for (int i = gt; i < T; i += NGT) { ssq_cq[i] = 0.f; ssq_lat[i] = 0.f; }
        for (int i = gt; i < (int)((WS_CTL_ZERO_END - WS_SSQY) / 4); i += NGT) ((unsigned*)(ws + WS_SSQY))[i] = 0u;
        { const int* pos = ap->pos;
        for (int i = gt; i < T * 32; i += NGT) { const int t = i >> 5, f = i & 31; const float ang = (float)pos[t] * ap->invf[f];
            double rev = (double)ang * 0.15915494309189535; rev -= rint(rev); const float rf = (float)rev;
            cosT[i] = __builtin_amdgcn_cosf(rf); sinT[i] = __builtin_amdgcn_sinf(rf); } }
        { u32x4 z = {0u, 0u, 0u, 0u};
          u32x4* p = (u32x4*)(ws + WS_WBIN + (size_t)1856 * 2048 * 2); for (int i = gt; i < 192 * 2048 * 2 / 16; i += NGT) p[i] = z;
          for (int i = gt; i < 3072 * 16; i += NGT) { const int row = i >> 4, c = i & 15; const int pnr = (row >> 8) & 1;
              *(u32x4*)(ws + WS_WGATE + ((size_t)row * 256 + (1 - pnr) * 128) * 2 + c * 16) = z; } }
        cvt_rows(ap->x, WSP(bf16_t, WS_HB), WSP(float, WS_RSTD), T, gw, NGW, lane);
        cvt_rows(ap->mem, WSP(bf16_t, WS_MEMB), WSP(float, WS_RSTDMEM), 1024, gw, NGW, lane);
        LAS float* scr = (LAS float*)(ldsl + wave * 16384);
        int it = gw;
#define JOB(W_, ldw_, scol_, ncols_, K_, gain_, dst_, ldk_, koff_, kind_, rbase_) tr_job(it, NGW, W_, ldw_, scol_, ncols_, K_, gain_, (bf16_t*)(ws + (dst_)), ldk_, koff_, kind_, rbase_, scr, lane);
#define JOBF(W_, ldw_, scol_, ncols_, K_, gain_, dst_, ldk_, koff_, kind_, rbase_) tr_job(it, NGW, W_, ldw_, scol_, ncols_, K_, gain_, (bf16_t*)(ws + (dst_)), ldk_, koff_, kind_, rbase_, scr, lane, true);
        JOB(ap->a_w_in, 3584, 0, 3584, 2048, ap->g_mix_pre, WS_WAIN, 2048, 0, 0, 0)
        JOB(ap->w_o, 2048, 0, 2048, 2048, nullptr, WS_WO0, 2048, 0, 0, 0)
        JOB(ap->w_ff1, 8192, 0, 8192, 2048, ap->g_mlp_pre, WS_WFF1_0, 2048, 0, 0, 0)
        JOB(ap->w_ff2, 2048, 0, 2048, 8192, nullptr, WS_WFF2_0, LDF, 0, 0, 0)
        JOB(ap->w_mem_k, 512, 0, 512, 2048, ap->g_mem, WS_WMEM0, 2048, 0, 0, 0)
        JOB(ap->w_mem_v, 512, 0, 512, 2048, ap->g_mem, WS_WMEM0, 2048, 0, 0, 512)
        JOB(ap->w_mem_k + 2048 * 512, 512, 0, 512, 2048, ap->g_mem + 2048, WS_WMEM1, 2048, 0, 0, 0)
        JOB(ap->w_mem_v + 2048 * 512, 512, 0, 512, 2048, ap->g_mem + 2048, WS_WMEM1, 2048, 0, 0, 512)
        JOBF(ap->w_o + 2048 * 2048, 2048, 0, 2048, 2048, nullptr, WS_WO1, 2048, 0, 0, 0)
        JOBF(ap->w_ff1 + 2048 * 8192, 8192, 0, 8192, 2048, ap->g_mlp_pre + 2048, WS_WFF1_1, 2048, 0, 0, 0)
        JOBF(ap->b_w_in, 1280, 0, 1280, 2048, ap->g_mix_pre + 2048, WS_WBIN, 2048, 0, 0, 0)
        JOBF(ap->kv_w_down, 576, 0, 512, 2048, ap->kv_g_in, WS_WBIN, 2048, 0, 0, 1280)
        JOBF(ap->kv_w_down, 576, 512, 64, 2048, ap->kv_g_in, WS_WBIN, 2048, 0, 2, 1792)
        JOBF(ap->b_w_qb, 2304, 0, 2304, 768, ap->b_g_qa, WS_WQB, 768, 0, 1, 0)
        JOBF(ap->kv_w_up, 3072, 0, 3072, 512, ap->kv_g_latent, WS_WUP, 512, 0, 0, 0)
        for (int blk = 0; blk < 12; ++blk) {
            JOB(ap->a_w_r + blk * 16384, 128, 0, 128, 128, nullptr, WS_WGATE + (size_t)(blk >> 1) * 512 * 256 * 2, 256, (blk & 1) * 128, 0, (blk & 1) * 256)
            JOB(ap->a_w_i + blk * 16384, 128, 0, 128, 128, nullptr, WS_WGATE + (size_t)(blk >> 1) * 512 * 256 * 2, 256, (blk & 1) * 128, 0, (blk & 1) * 256 + 128)
        }
#undef JOB
#undef JOBF
        __syncthreads();
    }
    cg::this_grid().sync();

    if ((PHMASK >> 1) & 1) { PHASE_BEGIN
        { EpiA1 e{WSP(bf16_t, WS_XBR), WSP(bf16_t, WS_GG), WSP(bf16_t, WS_QMA), WSP(const float, WS_RSTD)};
          RUN_GEMM(EpiA1, e, WSP(const bf16_t, WS_HB), WSP(const bf16_t, WS_WAIN), 2048, 2048, 2048, T, 3584, bx); }
        { EpiStd<0> e{WSP(bf16_t, WS_MEMKV), 1024, WSP(const float, WS_RSTDMEM), 0.f, 1.f};
          RUN_GEMM(EpiStd<0>, e, WSP(const bf16_t, WS_MEMB), WSP(const bf16_t, WS_WMEM0), 2048, 2048, 2048, 1024, 1024, (bx + G - 128 % G) % G); }
        { EpiStd<0> e{WSP(bf16_t, WS_MEMKV + 2 * MiB), 1024, WSP(const float, WS_RSTDMEM), 0.f, 1.f};
          RUN_GEMM(EpiStd<0>, e, WSP(const bf16_t, WS_MEMB), WSP(const bf16_t, WS_WMEM1), 2048, 2048, 2048, 1024, 1024, (bx + G - 144 % G) % G); }
        { const int nidle = G > 160 ? G - 160 : G, first = G > 160 ? 160 : 0;
          if (bx >= first) { LAS float* scr = (LAS float*)(ldsl + wave * 16384); int it = (bx - first) * 8 + wave;
              tr_job(it, nidle * 8, ap->w_ff2 + 2048 * 8192, 2048, 0, 2048, 8192, nullptr, WSP(bf16_t, WS_WFF2_1), LDF, 0, 0, 0, scr, lane, true); } }
    }
    SEAM();

    if ((PHMASK >> 2) & 1) { PHASE_BEGIN
        const bf16_t* xbr = WSP(const bf16_t, WS_XBR); bf16_t* xc = WSP(bf16_t, WS_XC); const float* cw = ap->a_conv_w; const float* cb = ap->a_conv_b;
        for (int task = gt; task < 512 * 192; task += NGT) { const int r = task / 192, c8 = (task - r * 192) * 8, t0 = r * 32;
            f32x4 wl[4], wh[4];
#pragma unroll
            for (int j = 0; j < 4; ++j) { wl[j] = *(const f32x4*)(cw + j * 1536 + c8); wh[j] = *(const f32x4*)(cw + j * 1536 + c8 + 4); }
            const f32x4 bl = *(const f32x4*)(cb + c8), bh = *(const f32x4*)(cb + c8 + 4);
            const bf16_t* xp = xbr + (size_t)t0 * 1536 + c8; bf16_t* op = xc + (size_t)t0 * 1536 + c8;
            u32x4 x0 = {0u, 0u, 0u, 0u}, x1 = x0, x2 = x0;
            if ((t0 & (SEQ - 1)) != 0) { x0 = *(const u32x4*)(xp - 3 * 1536); x1 = *(const u32x4*)(xp - 2 * 1536); x2 = *(const u32x4*)(xp - 1536); }
#define CMAC(al, ah, wlo, whi, xv) do { al[0] += wlo[0] * bflo(xv.x); al[1] += wlo[1] * bfhi(xv.x); al[2] += wlo[2] * bflo(xv.y); al[3] += wlo[3] * bfhi(xv.y); \
                ah[0] += whi[0] * bflo(xv.z); ah[1] += whi[1] * bfhi(xv.z); ah[2] += whi[2] * bflo(xv.w); ah[3] += whi[3] * bfhi(xv.w); } while (0)
#pragma unroll 8
            for (int s = 0; s < 32; ++s) { const u32x4 x3 = *(const u32x4*)(xp + (size_t)s * 1536);
                f32x4 a0 = bl, a1 = bh;
                CMAC(a0, a1, wl[0], wh[0], x0); CMAC(a0, a1, wl[1], wh[1], x1); CMAC(a0, a1, wl[2], wh[2], x2); CMAC(a0, a1, wl[3], wh[3], x3);
                u32x4 o; o.x = cvt_pk_bf16(a0[0], a0[1]); o.y = cvt_pk_bf16(a0[2], a0[3]); o.z = cvt_pk_bf16(a1[0], a1[1]); o.w = cvt_pk_bf16(a1[2], a1[3]);
                *(u32x4*)(op + (size_t)s * 1536) = o; x0 = x1; x1 = x2; x2 = x3; }
#undef CMAC
        }
        __syncthreads();
        for (int u = bx; u < 256; u += G) { const int qb = u & 15, h = (u >> 4) & 3, b = u >> 6;
            const bf16_t* mkv = WSP(const bf16_t, WS_MEMKV) + (size_t)(b * 256) * 1024 + h * 128;
            AttnArgs a{WSP(const bf16_t, WS_QMA) + (size_t)(b * SEQ + qb * 256) * 512 + h * 128, 512, mkv, 1024, nullptr, mkv + 512, 1024,
                       WSP(bf16_t, WS_CC) + (size_t)(b * SEQ + qb * 256) * DM + 1536 + h * 128, DM, 4, 1 << 20};
            attn_unit<8>(a, (char*)lds); }
    }
    SEAM();

    if ((PHMASK >> 3) & 1) { PHASE_BEGIN
        EpiGate e{WSP(const bf16_t, WS_XC), ap->a_b_r, ap->a_b_i, WSP(unsigned, WS_RU)};
        pg8::Gemm g_{WSP(const bf16_t, WS_XC), WSP(const bf16_t, WS_WGATE), 1536, 256, 256, 512, (size_t)512 * 256 * 2};
        SO S_; S_.init(T, 3072, G, bx, 2);
        pg8::gemm_phase<EpiGate, SO, true, true>(ldsl, g_, S_, e);
    }
    SEAM();

    if ((PHMASK >> 4) & 1) { PHASE_BEGIN
        const unsigned* RU = WSP(const unsigned, WS_RU); float2* agg = WSP(float2, WS_AGG); const float* lam = ap->a_lambda;
        for (int u = bx; u < 768; u += G) { const int slab = u % 3, k = (u / 3) & 63, b = u / 192, ch = slab * 512 + tid;
            const float c2 = -8.f * 1.4426950408889634f * log1pf(__expf(-lam[ch]));
            const unsigned* p = RU + (size_t)(b * SEQ + k * 64) * 1536 + ch; float Aa = 1.f, Bb = 0.f;
#pragma unroll 16
            for (int i = 0; i < 64; ++i) { const unsigned w = p[(size_t)i * 1536]; const float a = __builtin_amdgcn_exp2f(bflo(w) * c2);
                const float bb = sqrtf(fmaxf(1.f - a * a, 0.f)) * bfhi(w); Bb = a * Bb + bb; Aa *= a; }
            agg[(size_t)(b * 64 + k) * 1536 + ch] = make_float2(Aa, Bb); }
    }
    SEAM();

    if ((PHMASK >> 5) & 1) { PHASE_BEGIN
        const unsigned* RU = WSP(const unsigned, WS_RU); const float2* agg = WSP(const float2, WS_AGG); const bf16_t* gg = WSP(const bf16_t, WS_GG); const float* lam = ap->a_lambda;
        for (int u = bx; u < 768; u += G) { const int slab = u % 3, k = (u / 3) & 63, b = u / 192, ch = slab * 512 + tid;
            const float c2 = -8.f * 1.4426950408889634f * log1pf(__expf(-lam[ch]));
            float h = 0.f;
            for (int kk = 0; kk < k; kk += 8) { float2 ab[8];
#pragma unroll
                for (int j = 0; j < 8; ++j) ab[j] = (kk + j < k) ? agg[(size_t)(b * 64 + kk + j) * 1536 + ch] : make_float2(1.f, 0.f);
#pragma unroll
                for (int j = 0; j < 8; ++j) h = ab[j].x * h + ab[j].y; }
            const size_t r0 = (size_t)(b * SEQ + k * 64);
            const unsigned* p = RU + r0 * 1536 + ch; const bf16_t* gp = gg + r0 * 1536 + ch; bf16_t* op = WSP(bf16_t, WS_CC) + r0 * DM + ch;
#pragma unroll 16
            for (int i = 0; i < 64; ++i) { const unsigned w = __builtin_nontemporal_load(p + (size_t)i * 1536); const float a = __builtin_amdgcn_exp2f(bflo(w) * c2);
                const float bb = sqrtf(fmaxf(1.f - a * a, 0.f)) * bfhi(w); h = a * h + bb;
                const float gv = __uint_as_float((unsigned)__builtin_nontemporal_load(gp + (size_t)i * 1536) << 16);
                op[(size_t)i * DM] = (bf16_t)(cvt_pk_bf16(h * gv, 0.f) & 0xffffu); } }
    }
    SEAM();

#pragma unroll
    for (int layer = 0; layer < 2; ++layer) {
        if (layer == 1) {
            if ((PHMASK >> 6) & 1) { PHASE_BEGIN
                EpiB1 e{WSP(bf16_t, WS_CQ), WSP(bf16_t, WS_QMB), WSP(bf16_t, WS_CKV), WSP(bf16_t, WS_KPE), WSP(float, WS_SSQCQ), WSP(float, WS_SSQLAT), WSP(const float, WS_SSQH) + T, WSP(const float, WS_COS), WSP(const float, WS_SIN)};
                RUN_GEMM(EpiB1, e, WSP(const bf16_t, WS_HB), WSP(const bf16_t, WS_WBIN), 2048, 2048, 2048, T, 2048, bx);
            }
            SEAM();
            if ((PHMASK >> 7) & 1) { PHASE_BEGIN
                { EpiStd<0> e{WSP(bf16_t, WS_KV), 3072, WSP(const float, WS_SSQLAT), 1.f / 512.f, 1.f};
                  RUN_GEMM(EpiStd<0>, e, WSP(const bf16_t, WS_CKV), WSP(const bf16_t, WS_WUP), 512, 512, 512, T, 3072, bx); }
                { EpiQ e{WSP(bf16_t, WS_Q), WSP(const float, WS_SSQCQ), WSP(const float, WS_COS), WSP(const float, WS_SIN)};
                  RUN_GEMM(EpiQ, e, WSP(const bf16_t, WS_CQ), WSP(const bf16_t, WS_WQB), 768, 768, 768, T, 2304, bx); }
            }
            SEAM();
            if ((PHMASK >> 8) & 1) { PHASE_BEGIN
                for (int slot = 0; slot < (G == 256 ? ATT_SLOTS : 1024 / G + 1); ++slot) {
                    int code;
                    if (G == 256) code = g_att_sched[bx][slot]; else { const int p = slot * G + bx; code = p < 1024 ? (p < 768 ? p : 1024 + (p - 768)) : 0xFFFF; }
                    if (code == 0xFFFF) continue;
                    if (code < 1024) { const int qb = code & 15, bh = code >> 4, b = bh / 12, h = bh - b * 12;
                        const bf16_t* kv = WSP(const bf16_t, WS_KV) + (size_t)(b * SEQ) * 3072 + h * 256;
                        AttnArgs a{WSP(const bf16_t, WS_Q) + (size_t)(b * SEQ + qb * 256) * 2304 + h * 192, 2304, kv, 3072, WSP(const bf16_t, WS_KPE) + (size_t)(b * SEQ) * 64,
                                   kv + 128, 3072, WSP(bf16_t, WS_CC) + (size_t)(b * SEQ + qb * 256) * DM + h * 128, DM, 4 * qb + 4, 4 * qb};
                        attn_unit<12>(a, (char*)lds); }
                    else { const int u = code - 1024, qb = u & 15, h = (u >> 4) & 3, b = u >> 6;
                        const bf16_t* mkv = WSP(const bf16_t, WS_MEMKV + 2 * MiB) + (size_t)(b * 256) * 1024 + h * 128;
                        AttnArgs a{WSP(const bf16_t, WS_QMB) + (size_t)(b * SEQ + qb * 256) * 512 + h * 128, 512, mkv, 1024, nullptr, mkv + 512, 1024,
                                   WSP(bf16_t, WS_CC) + (size_t)(b * SEQ + qb * 256) * DM + 1536 + h * 128, DM, 4, 1 << 20};
                        attn_unit<8>(a, (char*)lds); }
                }
            }
            SEAM();
        }
        const size_t wo_off = layer ? WS_WO1 : WS_WO0, wf1_off = layer ? WS_WFF1_1 : WS_WFF1_0, wf2_off = layer ? WS_WFF2_1 : WS_WFF2_0;
#pragma unroll
        for (int hf = 0; hf < 2; ++hf) {
            if ((PHMASK >> 10) & 1) { PHASE_BEGIN
                LAS float* Pl = (LAS float*)(ldsl + 131072 + 1024);
                if (layer == 0) { EpiNorm<true, false> e{ap->x, WSP(bf16_t, WS_HB), nullptr, ap->g_mix_post, WSP(float, WS_SSQY), WSP(float, WS_SSQH), WSP(unsigned, WS_CNT), hf * 8192, Pl};
                    RUN_GEMM(EN_TF, e, WSP(const bf16_t, WS_CC) + (size_t)hf * 8192 * DM, (const bf16_t*)(ws + wo_off), 2048, 2048, 2048, 8192, 2048, bx); }
                else { EpiNorm<false, false> e{nullptr, WSP(bf16_t, WS_HB), nullptr, ap->g_mix_post + DM, WSP(float, WS_SSQY) + 2 * T, WSP(float, WS_SSQH) + 2 * T, WSP(unsigned, WS_CNT) + 2 * 64 * 64, hf * 8192, Pl};
                    RUN_GEMM(EN_FF, e, WSP(const bf16_t, WS_CC) + (size_t)hf * 8192 * DM, (const bf16_t*)(ws + wo_off), 2048, 2048, 2048, 8192, 2048, bx); }
            }
            if (hf == 1) SEAM();
        }
#pragma unroll
        for (int hf = 0; hf < 2; ++hf) {
            if ((PHMASK >> 12) & 1) { PHASE_BEGIN EpiStd<2> e{WSP(bf16_t, WS_F), LDF, WSP(const float, WS_SSQH) + (layer * 2) * T + hf * 8192, 1.f / DM, 1.f};
                RUN_GEMM(EpiStd<2>, e, WSP(const bf16_t, WS_HB) + (size_t)hf * 8192 * DM, (const bf16_t*)(ws + wf1_off), 2048, 2048, 2048, 8192, 8192, bx); }
            SEAM();
            if ((PHMASK >> 13) & 1) { PHASE_BEGIN
                LAS float* Pl = (LAS float*)(ldsl + 131072 + 1024);
                if (layer == 0) { EpiNorm<false, false> e{nullptr, WSP(bf16_t, WS_HB), nullptr, ap->g_mlp_post, WSP(float, WS_SSQY) + T, WSP(float, WS_SSQH) + T, WSP(unsigned, WS_CNT) + 64 * 64, hf * 8192, Pl};
                    RUN_GEMM(EN_FF, e, WSP(const bf16_t, WS_F), (const bf16_t*)(ws + wf2_off), LDF, LDF, 8192, 8192, 2048, bx); }
                else { EpiNorm<false, true> e{nullptr, WSP(bf16_t, WS_HB), ap->out, ap->g_mlp_post + DM, WSP(float, WS_SSQY) + 3 * T, WSP(float, WS_SSQH) + 3 * T, WSP(unsigned, WS_CNT) + 3 * 64 * 64, hf * 8192, Pl};
                    RUN_GEMM(EN_FT, e, WSP(const bf16_t, WS_F), (const bf16_t*)(ws + wf2_off), LDF, LDF, 8192, 8192, 2048, bx); }
            }
            if (!(layer == 1 && hf == 1)) SEAM();
        }
    }
#undef SEAM
}

extern "C" void kernel_launch(void* const* d_in, const int* in_sizes, int n_in, void* d_out, int out_size, void* d_ws, size_t ws_size, hipStream_t stream) {
    static int grid = 0;
    if (grid == 0) {
        if (n_in != 28 || in_sizes[0] != T * DM || out_size != T * DM || ws_size < WS_END) {
            fprintf(stderr, "kernel_launch: unexpected shapes: n_in %d in0 %d out %d ws %zu (need %zu)\n", n_in, n_in > 0 ? in_sizes[0] : -1, out_size, ws_size, (size_t)WS_END); grid = -1; return; }
        int dev = 0, cus = 0, per_cu = 0;
        (void)hipGetDevice(&dev); (void)hipDeviceGetAttribute(&cus, hipDeviceAttributeMultiprocessorCount, dev);
        if (hipFuncSetAttribute((const void*)fwd_mega, hipFuncAttributeMaxDynamicSharedMemorySize, LDS_BYTES) != hipSuccess) fprintf(stderr, "kernel_launch: hipFuncSetAttribute failed\n");
        if (hipOccupancyMaxActiveBlocksPerMultiprocessor(&per_cu, (const void*)fwd_mega, 512, LDS_BYTES) != hipSuccess || per_cu < 1) { fprintf(stderr, "kernel_launch: occupancy query says %d\n", per_cu); per_cu = 1; }
        (void)hipGetLastError();
        grid = cus * 1;
        if (grid <= 0) grid = 256;
    }
    if (grid < 0) return;
    Args a{};
    a.x = (const float*)d_in[0]; a.mem = (const float*)d_in[1]; a.pos = (const int*)d_in[2];
    a.g_mix_pre = (const float*)d_in[3]; a.g_mix_post = (const float*)d_in[4]; a.g_mlp_pre = (const float*)d_in[5]; a.g_mlp_post = (const float*)d_in[6]; a.g_mem = (const float*)d_in[7];
    a.w_mem_k = (const float*)d_in[8]; a.w_mem_v = (const float*)d_in[9]; a.w_o = (const float*)d_in[10]; a.w_ff1 = (const float*)d_in[11]; a.w_ff2 = (const float*)d_in[12];
    a.a_w_in = (const float*)d_in[13]; a.a_conv_w = (const float*)d_in[14]; a.a_conv_b = (const float*)d_in[15]; a.a_w_r = (const float*)d_in[16]; a.a_b_r = (const float*)d_in[17];
    a.a_w_i = (const float*)d_in[18]; a.a_b_i = (const float*)d_in[19]; a.a_lambda = (const float*)d_in[20];
    a.b_w_in = (const float*)d_in[21]; a.b_g_qa = (const float*)d_in[22]; a.b_w_qb = (const float*)d_in[23];
    a.kv_g_in = (const float*)d_in[24]; a.kv_w_down = (const float*)d_in[25]; a.kv_g_latent = (const float*)d_in[26]; a.kv_w_up = (const float*)d_in[27 + 0];
    a.out = (float*)d_out; a.ws = (unsigned char*)d_ws;
    for (int i = 0; i < 32; ++i) a.invf[i] = (float)pow(10000.0, -(double)i / 32.0);
    a.ph_lo = 0; a.ph_hi = 1000;
    (void)hipMemsetAsync((unsigned char*)d_ws + WS_BAR, 0, 16384, stream);
    void* kargs[] = {&a};
    hipError_t e = hipLaunchCooperativeKernel((const void*)fwd_mega, dim3(grid), dim3(512), kargs, LDS_BYTES, stream);
    if (e != hipSuccess) fprintf(stderr, "kernel_launch: cooperative launch failed: %s (grid %d)\n", hipGetErrorString(e), grid);
}
```

```cpp
#include <hip/hip_runtime.h>
#include <hip/hip_cooperative_groups.h>
#include <cstdio>
#include <cstdint>
#include <cmath>
namespace cg = cooperative_groups;

#define LAS __attribute__((address_space(3)))
typedef unsigned short bf16_t;
typedef short bf16x8 __attribute__((ext_vector_type(8)));
typedef short s16x4 __attribute__((ext_vector_type(4)));
typedef float f32x4 __attribute__((ext_vector_type(4)));
typedef float f32x16 __attribute__((ext_vector_type(16)));
typedef unsigned u32x4 __attribute__((ext_vector_type(4)));
typedef unsigned u32x2 __attribute__((ext_vector_type(2)));

constexpr int T = 16384, DM = 2048, SEQ = 4096, NBATCH = 4;
constexpr float EPS = 1e-6f;
constexpr float MEMSCALE = 0.08838834764831845f * 1.4426950408889634f;
constexpr float QSCALE = 0.07216878364870322f * 1.4426950408889634f;
constexpr size_t MiB = 1u << 20;
constexpr size_t WS_RSTD = 0, WS_SSQCQ = 65536, WS_SSQLAT = 131072, WS_RSTDMEM = 196608;
constexpr size_t WS_BAR = 262144;
constexpr size_t WS_SSQY = 320 * 1024, WS_SSQH = 576 * 1024, WS_CNT = 832 * 1024, WS_CTL_ZERO_END = 896 * 1024;
constexpr size_t WS_MEMKV = 1 * MiB;
constexpr size_t WS_COS = 5 * MiB, WS_SIN = 7 * MiB;
constexpr int LDF = 8192 + 64;
constexpr size_t KiB = 1024;
constexpr size_t WS_WAIN = 9 * MiB, WS_WO0 = 23 * MiB, WS_WFF1_0 = 31 * MiB, WS_WFF2_0 = 63 * MiB, WS_WGATE = 95 * MiB + 256 * KiB, WS_WMEM0 = 96 * MiB + 768 * KiB, WS_WMEM1 = 100 * MiB + 768 * KiB,
                 WS_WO1 = 104 * MiB + 768 * KiB, WS_WFF1_1 = 112 * MiB + 768 * KiB, WS_WFF2_1 = 144 * MiB + 768 * KiB, WS_WBIN = 177 * MiB, WS_WQB = 185 * MiB, WS_WUP = 188 * MiB + 384 * KiB;
static_assert(WS_WFF2_0 + (size_t)2048 * LDF * 2 <= WS_WGATE && WS_WFF2_1 + (size_t)2048 * LDF * 2 <= WS_WBIN && WS_WUP + 3 * MiB <= 192 * MiB, "weight map");
constexpr size_t WS_HB = 192 * MiB, WS_Y = 256 * MiB, WS_CC = 320 * MiB, WS_ARENA = 384 * MiB, WS_END = 512 * MiB;
constexpr size_t WS_GG = WS_Y;
constexpr size_t WS_MEMB = WS_Y + 48 * MiB;
constexpr size_t WS_XBR = WS_ARENA, WS_QMA = WS_ARENA + 48 * MiB;
constexpr size_t WS_XC = WS_HB;
constexpr size_t WS_RU = WS_ARENA;
constexpr size_t WS_AGG = WS_ARENA + 96 * MiB;
constexpr size_t WS_F = WS_ARENA - 1 * MiB;
constexpr size_t WS_CQ = WS_Y, WS_QMB = WS_Y + 24 * MiB, WS_CKV = WS_Y + 40 * MiB, WS_KPE = WS_Y + 56 * MiB;
constexpr size_t WS_Q = WS_WAIN;
constexpr size_t WS_KV = WS_ARENA;
static_assert(WS_F + (size_t)8192 * LDF * 2 <= WS_END && WS_Q + 72 * MiB <= WS_WMEM1 + 4 * MiB, "map");

namespace pg8 {
constexpr int BM = 256, BK = 64, HALF = 128, HTB = HALF * BK * 2, STAGE_BYTES = 8 * HTB, NXCD = 8, WGM = 8;
__host__ __device__ __forceinline__ int lds_byte(int r, int c) { const int st = (r >> 4) * 2 + (c >> 5), rr = r & 15, cc = c & 31, ob = rr * 64 + cc * 2; return st * 1024 + (ob ^ (((ob >> 9) & 1) << 5)); }
__host__ __device__ __forceinline__ void stage_rc(int b, int& R, int& C) { const int st = b / 1024, sb = b % 1024, swz = sb ^ (((sb >> 9) & 1) << 5); R = (st >> 1) * 16 + swz / 64; C = (st & 1) * 32 + (swz % 64) / 2; }
__host__ __device__ __forceinline__ int perm32(int rho) { const int n = rho >> 4, i = rho & 15; return 8 * (i >> 2) + 4 * n + (i & 3); }

struct Unit { int pm, pn, g; };
struct Gemm { const bf16_t* A; const bf16_t* Bt; int lda, ldb, K; size_t gsA, gsB; };

struct StaticOrder {
    int nM, nN, nwg, G, c, gdiv;
    __device__ void init(int M, int N, int G_, int c_, int gdiv_ = 1 << 20) { nM = M / BM; nN = N / BM; nwg = nM * nN; G = G_; c = c_; gdiv = gdiv_; }
    __device__ bool next(int i, Unit& u) const {
        const long L = (long)i * G + c; if (L >= nwg) return false;
        int wgid = (int)L; { const int q = nwg / NXCD, r = nwg % NXCD, xcd = wgid % NXCD, off = wgid / NXCD; wgid = (xcd < r ? xcd * (q + 1) : r * (q + 1) + (xcd - r) * q) + off; }
        const int nig = WGM * nN, gid = wgid / nig, fm = gid * WGM, gsz = (nM - fm) < WGM ? (nM - fm) : WGM;
        u.pm = fm + ((wgid % nig) % gsz); const int pnv = (wgid % nig) / gsz; u.g = pnv / gdiv; u.pn = pnv - u.g * gdiv; return true;
    }
    __device__ __forceinline__ void a_ready(const Unit&) const {}
    __device__ __forceinline__ void done(const Unit&) const {}
};

__device__ __forceinline__ unsigned cvt_pk_bf16(float lo, float hi) { unsigned r; asm volatile("v_cvt_pk_bf16_f32 %0, %1, %2" : "=v"(r) : "v"(lo), "v"(hi)); return r; }

template <class Epi, class Sched, bool ALIGN_EPI = false, bool SP2 = false>
__device__ __forceinline__ void gemm_phase(LAS unsigned char* lds, const Gemm g, const Sched& S, const Epi& E) {
    int tid_ = threadIdx.x; asm volatile("" : "+v"(tid_));
    const int tid = tid_, wid = __builtin_amdgcn_readfirstlane(tid >> 6), lane = tid & 63, wr = wid >> 2, wc = wid & 3, fr = lane & 15, fq = lane >> 4;
    const int K = g.K, nt = K / BK;
    unsigned voffA[2], voffB[2];
#pragma unroll
    for (int i = 0; i < 2; ++i) { int R, C; stage_rc(tid * 16 + i * 8192, R, C); const int Rb = Epi::PERM ? ((R & ~31) + perm32(R & 31)) : R;
        voffA[i] = (unsigned)(R * g.lda + C) * 2u; voffB[i] = (unsigned)(Rb * g.ldb + C) * 2u; }
    const size_t kstep = (size_t)(BK * 2);
    const size_t hstepA = (size_t)HALF * g.lda * 2, hstepB = (size_t)HALF * g.ldb * 2;
    const size_t tstepA = 2 * hstepA, tstepB = 2 * hstepB;
    const unsigned ldsw = (unsigned)wid * 1024u;
    const int aoff = lds_byte(wr * 64 + fr, fq * 8), boff = lds_byte(wc * 32 + fr, fq * 8);
#define PG8_SA(b, h) (((b) * 2 + (h)) * HTB)
#define PG8_SB(b, h) ((4 + (b) * 2 + (h)) * HTB)
#define PG8_STAGE(bufoff, gbase, voff) do { _Pragma("unroll") for (int _i = 0; _i < 2; ++_i) \
        __builtin_amdgcn_global_load_lds((const unsigned*)((const char*)(gbase) + (voff)[_i]), (LAS unsigned*)(lds + (bufoff) + ldsw + _i * 8192), 16, 0, 0); } while (0)
#define PG8_LDA(dst, b, h) do { _Pragma("unroll") for (int m = 0; m < 4; ++m) _Pragma("unroll") for (int k = 0; k < 2; ++k) dst[m][k] = *(const LAS bf16x8*)(lds + PG8_SA(b, h) + aoff + m * 2048 + k * 1024); } while (0)
#define PG8_LDB(dst, b, h) do { _Pragma("unroll") for (int n = 0; n < 2; ++n) _Pragma("unroll") for (int k = 0; k < 2; ++k) dst[n][k] = *(const LAS bf16x8*)(lds + PG8_SB(b, h) + boff + n * 2048 + k * 1024); } while (0)
#define PG8_MMA(ai, bj, At, Bt) do { __builtin_amdgcn_s_setprio(1); _Pragma("unroll") for (int m = 0; m < 4; ++m) _Pragma("unroll") for (int n = 0; n < 2; ++n) _Pragma("unroll") for (int k = 0; k < 2; ++k) \
        acc[ai][bj][m][n] = __builtin_amdgcn_mfma_f32_16x16x32_bf16(Bt[n][k], At[m][k], acc[ai][bj][m][n], 0, 0, 0); __builtin_amdgcn_s_setprio(0); } while (0)
#define PG8_WAIT_V(n) asm volatile("s_waitcnt vmcnt(" #n ")" ::: "memory")
#define PG8_WAIT_L(n) asm volatile("s_waitcnt lgkmcnt(" #n ")" ::: "memory")
#define PG8_BAR __builtin_amdgcn_s_barrier()
#define PG8_SCHED __builtin_amdgcn_sched_barrier(0)
    Unit cur, nxt; int ui = 0;
    if (!S.next(0, cur)) return;
    f32x4 acc[2][2][4][2];
#pragma unroll
    for (int a = 0; a < 2; ++a)
#pragma unroll
        for (int b = 0; b < 2; ++b)
#pragma unroll
            for (int m = 0; m < 4; ++m)
#pragma unroll
                for (int n = 0; n < 2; ++n) acc[a][b][m][n] = (f32x4){0.f, 0.f, 0.f, 0.f};
    bf16x8 At[4][2], B0[2][2], B1[2][2];
    const char* cA = (const char*)g.A + (size_t)cur.g * g.gsA + (size_t)cur.pm * tstepA; const char* cB = (const char*)g.Bt + (size_t)cur.g * g.gsB + (size_t)cur.pn * tstepB;
    S.a_ready(cur);
    if constexpr (SP2) {
        PG8_STAGE(PG8_SB(0, 0), cB, voffB); PG8_STAGE(PG8_SB(0, 1), cB + hstepB, voffB); PG8_STAGE(PG8_SA(0, 0), cA, voffA); PG8_STAGE(PG8_SA(0, 1), cA + hstepA, voffA);
        if (wr == 1) PG8_BAR;
        PG8_WAIT_V(2); PG8_BAR;
        PG8_STAGE(PG8_SB(1, 0), cB + kstep, voffB); PG8_STAGE(PG8_SA(1, 0), cA + kstep, voffA); PG8_STAGE(PG8_SB(1, 1), cB + hstepB + kstep, voffB);
        PG8_WAIT_V(6); PG8_BAR;
    } else {
        PG8_STAGE(PG8_SB(0, 0), cB, voffB); PG8_STAGE(PG8_SA(0, 0), cA, voffA); PG8_STAGE(PG8_SB(0, 1), cB + hstepB, voffB); PG8_STAGE(PG8_SA(0, 1), cA + hstepA, voffA);
        if (wr == 1) PG8_BAR;
        PG8_WAIT_V(4); PG8_BAR;
        PG8_STAGE(PG8_SB(1, 0), cB + kstep, voffB); PG8_STAGE(PG8_SA(1, 0), cA + kstep, voffA); PG8_STAGE(PG8_SB(1, 1), cB + hstepB + kstep, voffB);
        PG8_WAIT_V(6); PG8_BAR;
    }
    for (;;) {
        const bool has_next = S.next(ui + 1, nxt);
        const char* nA = has_next ? (const char*)g.A + (size_t)nxt.g * g.gsA + (size_t)nxt.pm * tstepA : cA; const char* nB = has_next ? (const char*)g.Bt + (size_t)nxt.g * g.gsB + (size_t)nxt.pn * tstepB : cB;
        for (int t = 0; t < nt; t += 2) {
            const bool last = (t == nt - 2);
            const char* a1 = cA + (size_t)(t + 1) * kstep;
            const char* a2 = last ? nA : cA + (size_t)(t + 2) * kstep; const char* b2 = last ? nB : cB + (size_t)(t + 2) * kstep;
            const char* a3 = a2 + kstep; const char* b3 = b2 + kstep;
            if (last && has_next) S.a_ready(nxt);
            if constexpr (SP2) {
            PG8_LDB(B0, 0, 0); PG8_LDB(B1, 0, 1); PG8_SCHED; PG8_LDA(At, 0, 0); PG8_STAGE(PG8_SA(1, 1), a1 + hstepA, voffA);
            PG8_WAIT_V(8); PG8_WAIT_L(0); PG8_BAR; PG8_MMA(0, 0, At, B0); PG8_MMA(0, 1, At, B1); PG8_BAR; PG8_SCHED;
            PG8_LDA(At, 0, 1); PG8_STAGE(PG8_SB(0, 0), b2, voffB); PG8_STAGE(PG8_SB(0, 1), b2 + hstepB, voffB); PG8_STAGE(PG8_SA(0, 0), a2, voffA);
            PG8_WAIT_V(8); PG8_WAIT_L(0); PG8_BAR; PG8_MMA(1, 0, At, B0); PG8_MMA(1, 1, At, B1); PG8_BAR; PG8_SCHED;
            PG8_LDB(B0, 1, 0); PG8_LDB(B1, 1, 1); PG8_SCHED; PG8_LDA(At, 1, 0); PG8_STAGE(PG8_SA(0, 1), a2 + hstepA, voffA);
            PG8_WAIT_V(8); PG8_WAIT_L(0); PG8_BAR; PG8_MMA(0, 0, At, B0); PG8_MMA(0, 1, At, B1); PG8_BAR; PG8_SCHED;
            PG8_LDA(At, 1, 1); PG8_STAGE(PG8_SB(1, 0), b3, voffB); PG8_STAGE(PG8_SB(1, 1), b3 + hstepB, voffB); PG8_STAGE(PG8_SA(1, 0), a3, voffA);
            PG8_WAIT_V(8); PG8_WAIT_L(0); PG8_BAR; PG8_MMA(1, 0, At, B0); PG8_MMA(1, 1, At, B1); PG8_BAR; PG8_SCHED;
            } else {
            PG8_LDB(B0, 0, 0); PG8_SCHED; PG8_LDA(At, 0, 0); PG8_STAGE(PG8_SA(1, 1), a1 + hstepA, voffA);
            PG8_WAIT_L(8); PG8_BAR; PG8_WAIT_L(0); PG8_MMA(0, 0, At, B0); PG8_BAR; PG8_SCHED;
            PG8_LDB(B1, 0, 1); PG8_STAGE(PG8_SB(0, 0), b2, voffB);
            PG8_BAR; PG8_WAIT_L(0); PG8_MMA(0, 1, At, B1); PG8_BAR;
            PG8_LDA(At, 0, 1); PG8_STAGE(PG8_SA(0, 0), a2, voffA);
            PG8_BAR; PG8_WAIT_L(0); PG8_MMA(1, 0, At, B0); PG8_BAR; PG8_SCHED;
            PG8_STAGE(PG8_SB(0, 1), b2 + hstepB, voffB);
            PG8_WAIT_V(6); PG8_BAR; PG8_MMA(1, 1, At, B1); PG8_BAR;
            PG8_LDB(B0, 1, 0); PG8_SCHED; PG8_LDA(At, 1, 0); PG8_STAGE(PG8_SA(0, 1), a2 + hstepA, voffA);
            PG8_WAIT_L(8); PG8_BAR; PG8_WAIT_L(0); PG8_MMA(0, 0, At, B0); PG8_BAR; PG8_SCHED;
            PG8_LDB(B1, 1, 1); PG8_STAGE(PG8_SB(1, 0), b3, voffB);
            PG8_BAR; PG8_WAIT_L(0); PG8_MMA(0, 1, At, B1); PG8_BAR;
            PG8_LDA(At, 1, 1); PG8_STAGE(PG8_SA(1, 0), a3, voffA);
            PG8_BAR; PG8_WAIT_L(0); PG8_MMA(1, 0, At, B0); PG8_BAR; PG8_SCHED;
            PG8_STAGE(PG8_SB(1, 1), b3 + hstepB, voffB);
            PG8_WAIT_V(6); PG8_BAR; PG8_MMA(1, 1, At, B1); PG8_BAR;
            }
        }
        if constexpr (ALIGN_EPI) { if (wr == 0) PG8_BAR; }
        { int fr2 = fr, fq2 = fq; asm volatile("" : "+v"(fr2), "+v"(fq2)); E(acc, cur, wr, wc, fr2, fq2); } S.done(cur);
        if (!has_next) break;
#pragma unroll
        for (int a = 0; a < 2; ++a)
#pragma unroll
            for (int b = 0; b < 2; ++b)
#pragma unroll
                for (int m = 0; m < 4; ++m)
#pragma unroll
                    for (int n = 0; n < 2; ++n) acc[a][b][m][n] = (f32x4){0.f, 0.f, 0.f, 0.f};
        cur = nxt; cA = nA; cB = nB; ++ui;
        if constexpr (ALIGN_EPI) { if (wr == 1) PG8_BAR; }
    }
    PG8_WAIT_V(0);
    if constexpr (!ALIGN_EPI) { if (wr == 0) PG8_BAR; }
    PG8_BAR;
#undef PG8_SA
#undef PG8_SB
#undef PG8_STAGE
#undef PG8_LDA
#undef PG8_LDB
#undef PG8_MMA
#undef PG8_WAIT_V
#undef PG8_WAIT_L
#undef PG8_BAR
#undef PG8_SCHED
}
}
using pg8::cvt_pk_bf16;
using pg8::HALF;

__device__ __forceinline__ float bflo(unsigned w) { return __uint_as_float(w << 16); }
__device__ __forceinline__ float bfhi(unsigned w) { return __uint_as_float(w & 0xffff0000u); }
__device__ __forceinline__ float wave_sum(float v) {
#pragma unroll
    for (int o = 1; o < 64; o <<= 1) v += __shfl_xor(v, o);
    return v;
}
__device__ __forceinline__ float fast_sigmoid(float x) { return __builtin_amdgcn_rcpf(1.f + __builtin_amdgcn_exp2f(-1.4426950408889634f * x)); }
__device__ __forceinline__ float gelu_tanh(float v) { const float u = v + 0.044715f * v * v * v; return v * __builtin_amdgcn_rcpf(1.f + __builtin_amdgcn_exp2f(-2.302208198f * u)); }

template <int ACT, bool NT = false>
__device__ __forceinline__ void store_perm(const f32x4 (&acc)[2][2][4][2], bf16_t* O, int ldc, int orow, int ocol, const float* rs, float inv_n, int grow, float cs) {
#pragma unroll
    for (int ai = 0; ai < 2; ++ai)
#pragma unroll
        for (int m = 0; m < 4; ++m) {
            const int ro = ai * HALF + m * 16;
            float s = cs;
            if (rs) { const float q = rs[grow + ro]; s *= (inv_n > 0.f) ? rsqrtf(q * inv_n + EPS) : q; }
            bf16_t* rowp = O + (size_t)(orow + ro) * ldc + ocol;
#pragma unroll
            for (int bj = 0; bj < 2; ++bj) {
                f32x4 v0 = acc[ai][bj][m][0] * s, v1 = acc[ai][bj][m][1] * s;
                if (ACT == 1) {
#pragma unroll
                    for (int j = 0; j < 4; ++j) { v0[j] = gelu_tanh(v0[j]); v1[j] = gelu_tanh(v1[j]); } }
                if (ACT == 2) {
#pragma unroll
                    for (int j = 0; j < 4; ++j) { const float a = fmaxf(v0[j], 0.f), b = fmaxf(v1[j], 0.f); v0[j] = a * a; v1[j] = b * b; } }
                u32x4 w; w.x = cvt_pk_bf16(v0[0], v0[1]); w.y = cvt_pk_bf16(v0[2], v0[3]); w.z = cvt_pk_bf16(v1[0], v1[1]); w.w = cvt_pk_bf16(v1[2], v1[3]);
                if (NT) __builtin_nontemporal_store(w, (u32x4*)(rowp + bj * HALF)); else *(u32x4*)(rowp + bj * HALF) = w;
            }
        }
}
template <int ACT> struct EpiStd {
    static constexpr bool PERM = true;
    bf16_t* O; int ldc; const float* rs; float inv_n; float cs;
    __device__ __forceinline__ void operator()(const f32x4 (&acc)[2][2][4][2], const pg8::Unit& u, int wr, int wc, int fr, int fq) const {
        const int grow = u.pm * 256 + wr * 64 + fr;
        store_perm<ACT>(acc, O, ldc, grow, u.pn * 256 + wc * 32 + 8 * fq, rs, inv_n, grow, cs);
    }
};
struct EpiA1 {
    static constexpr bool PERM = true;
    bf16_t *xbr, *gg, *qm; const float* rs;
    __device__ __forceinline__ void operator()(const f32x4 (&acc)[2][2][4][2], const pg8::Unit& u, int wr, int wc, int fr, int fq) const {
        const int grow = u.pm * 256 + wr * 64 + fr, cl = wc * 32 + 8 * fq;
        if (u.pn < 6) store_perm<0>(acc, xbr, 1536, grow, u.pn * 256 + cl, rs, 0.f, grow, 1.f);
        else if (u.pn < 12) store_perm<1, true>(acc, gg, 1536, grow, (u.pn - 6) * 256 + cl, rs, 0.f, grow, 1.f);
        else store_perm<0>(acc, qm, 512, grow, (u.pn - 12) * 256 + cl, rs, 0.f, grow, MEMSCALE);
    }
};
struct EpiGate {
    static constexpr bool PERM = false;
    const bf16_t* xc; const float *br, *bi; unsigned* RU;
    __device__ __forceinline__ void operator()(const f32x4 (&acc)[2][2][4][2], const pg8::Unit& u, int wr, int wc, int fr, int fq) const {
        const int blk = 2 * u.g + u.pn, row0 = u.pm * 256 + wr * 64 + fr, chb = blk * 128 + wc * 32 + 4 * fq;
#pragma unroll
        for (int ai = 0; ai < 2; ++ai)
#pragma unroll
            for (int m = 0; m < 4; ++m) {
#pragma unroll
                for (int n = 0; n < 2; ++n) {
                    const int ch = chb + 16 * n;
                    const size_t off = (size_t)(row0 + ai * HALF + m * 16) * 1536 + ch;
                    const u32x2 xw = *(const u32x2*)(xc + off);
                    const f32x4 ar = acc[ai][0][m][n] + *(const f32x4*)(br + ch), aiv = acc[ai][1][m][n] + *(const f32x4*)(bi + ch);
                    u32x4 w;
                    w.x = cvt_pk_bf16(fast_sigmoid(ar[0]), fast_sigmoid(aiv[0]) * bflo(xw.x));
                    w.y = cvt_pk_bf16(fast_sigmoid(ar[1]), fast_sigmoid(aiv[1]) * bfhi(xw.x));
                    w.z = cvt_pk_bf16(fast_sigmoid(ar[2]), fast_sigmoid(aiv[2]) * bflo(xw.y));
                    w.w = cvt_pk_bf16(fast_sigmoid(ar[3]), fast_sigmoid(aiv[3]) * bfhi(xw.y));
                    *(u32x4*)(RU + off) = w;
                }
                asm volatile("" ::: "memory");
            }
    }
};
__device__ __forceinline__ void st4bf(bf16_t* p, f32x4 v) { u32x2 w; w.x = cvt_pk_bf16(v[0], v[1]); w.y = cvt_pk_bf16(v[2], v[3]); *(u32x2*)p = w; }
struct EpiB1 {
    static constexpr bool PERM = false;
    bf16_t *cq, *qm, *ckv, *kpe; float *ssq_cq, *ssq_lat; const float *rs, *cosT, *sinT;
    __device__ __forceinline__ void operator()(const f32x4 (&acc)[2][2][4][2], const pg8::Unit& u, int wr, int wc, int fr, int fq) const {
        const int row0 = u.pm * 256 + wr * 64 + fr, pn = u.pn;
        if (pn == 7) {
            if (wc < 2) {
                const int j = 16 * wc + 4 * fq;
#pragma unroll
                for (int ai = 0; ai < 2; ++ai)
#pragma unroll
                    for (int m = 0; m < 4; ++m) {
                        const int row = row0 + ai * HALF + m * 16; const float s = rsqrtf(rs[row] * (1.f / DM) + EPS);
                        const f32x4 c4 = *(const f32x4*)(cosT + (size_t)row * 32 + j), s4 = *(const f32x4*)(sinT + (size_t)row * 32 + j);
                        const f32x4 x1 = acc[ai][0][m][0] * s, x2 = acc[ai][0][m][1] * s;
                        st4bf(kpe + (size_t)row * 64 + j, x1 * c4 - x2 * s4); st4bf(kpe + (size_t)row * 64 + j + 32, x2 * c4 + x1 * s4);
                    }
            }
            return;
        }
        bf16_t* O; int ldc, ocol; float cs; float* ssq;
        if (pn < 3) { O = cq; ldc = 768; ocol = pn * 256; cs = 1.f; ssq = ssq_cq; }
        else if (pn < 5) { O = qm; ldc = 512; ocol = (pn - 3) * 256; cs = MEMSCALE; ssq = nullptr; }
        else { O = ckv; ldc = 512; ocol = (pn - 5) * 256; cs = 1.f; ssq = ssq_lat; }
        ocol += wc * 32 + 4 * fq;
#pragma unroll
        for (int ai = 0; ai < 2; ++ai)
#pragma unroll
            for (int m = 0; m < 4; ++m) {
                const int row = row0 + ai * HALF + m * 16; const float s = rsqrtf(rs[row] * (1.f / DM) + EPS) * cs; float part = 0.f;
#pragma unroll
                for (int bj = 0; bj < 2; ++bj)
#pragma unroll
                    for (int n = 0; n < 2; ++n) { const f32x4 v = acc[ai][bj][m][n] * s; part += (v[0] * v[0] + v[1] * v[1]) + (v[2] * v[2] + v[3] * v[3]);
                        st4bf(O + (size_t)row * ldc + ocol + bj * HALF + 16 * n, v); }
                if (ssq) { part += __shfl_xor(part, 16); part += __shfl_xor(part, 32); if (fq == 0) atomicAdd(ssq + row, part); }
            }
    }
};
struct EpiQ {
    static constexpr bool PERM = false;
    bf16_t* Q; const float *ssq, *cosT, *sinT;
    __device__ __forceinline__ void operator()(const f32x4 (&acc)[2][2][4][2], const pg8::Unit& u, int wr, int wc, int fr, int fq) const {
        const int row0 = u.pm * 256 + wr * 64 + fr;
#pragma unroll
        for (int ai = 0; ai < 2; ++ai)
#pragma unroll
            for (int m = 0; m < 4; ++m) {
                const int row = row0 + ai * HALF + m * 16; const float s = rsqrtf(ssq[row] * (1.f / 768.f) + EPS) * QSCALE;
#pragma unroll
                for (int bj = 0; bj < 2; ++bj) {
                    const int g64 = 4 * u.pn + 2 * bj + (wc >> 1), head = g64 / 3, part = g64 - head * 3;
                    if (part < 2) {
#pragma unroll
                        for (int n = 0; n < 2; ++n) st4bf(Q + (size_t)row * 2304 + u.pn * 256 + bj * HALF + wc * 32 + 16 * n + 4 * fq, acc[ai][bj][m][n] * s);
                    } else {
                        const int j = 16 * (wc & 1) + 4 * fq;
                        const f32x4 c4 = *(const f32x4*)(cosT + (size_t)row * 32 + j), s4 = *(const f32x4*)(sinT + (size_t)row * 32 + j);
                        const f32x4 x1 = acc[ai][bj][m][0] * s, x2 = acc[ai][bj][m][1] * s;
                        bf16_t* qp = Q + (size_t)row * 2304 + head * 192 + 128 + j;
                        st4bf(qp, x1 * c4 - x2 * s4); st4bf(qp + 32, x2 * c4 + x1 * s4);
                    }
                }
            }
    }
};

template <bool BASE_F32, bool OUT_F32> struct EpiNorm {
    static constexpr bool PERM = true;
    const float* baseF; bf16_t* HBio; float* outF; const float* g; float* ssqY; float* ssqH; unsigned* cnt; int row_off; LAS float* P;
    __device__ __forceinline__ void operator()(const f32x4 (&acc)[2][2][4][2], const pg8::Unit& u, int wr, int wc, int fr_, int fq_) const {
        int fr = fr_, fq = fq_; asm volatile("" : "+v"(fr), "+v"(fq));
        const int tid = (wr * 4 + wc) * 64 + fq * 16 + fr;
        const int prow = row_off + u.pm * 256;
        const int lrow = wr * 64 + fr, col0 = u.pn * 256 + wc * 32 + 8 * fq;
        u32x4 bw[2][2];
        if (!BASE_F32) {
#pragma unroll
            for (int i = 0; i < 2; ++i)
#pragma unroll
                for (int bj = 0; bj < 2; ++bj) bw[i][bj] = *(const u32x4*)(HBio + (size_t)(prow + lrow + i * 16) * DM + col0 + bj * HALF);
        }
#pragma unroll
        for (int ai = 0; ai < 2; ++ai)
#pragma unroll
            for (int m = 0; m < 4; ++m) { float p = 0.f;
#pragma unroll
                for (int bj = 0; bj < 2; ++bj)
#pragma unroll
                    for (int n = 0; n < 2; ++n) { const f32x4 v = acc[ai][bj][m][n]; p += (v[0] * v[0] + v[1] * v[1]) + (v[2] * v[2] + v[3] * v[3]); }
                p += __shfl_xor(p, 16); p += __shfl_xor(p, 32);
                if (fq == 0) P[(ai * HALF + wr * 64 + m * 16 + fr) * 4 + wc] = p; }
        asm volatile("s_waitcnt lgkmcnt(0)" ::: "memory"); __builtin_amdgcn_s_barrier(); asm volatile("" ::: "memory");
        if (tid < 256) { const float s = (P[tid * 4 + 0] + P[tid * 4 + 1]) + (P[tid * 4 + 2] + P[tid * 4 + 3]);
            (void)__hip_atomic_fetch_add(ssqY + prow + tid, s, __ATOMIC_RELAXED, __HIP_MEMORY_SCOPE_AGENT); }
        asm volatile("s_waitcnt vmcnt(0) lgkmcnt(0)" ::: "memory"); __builtin_amdgcn_s_barrier(); asm volatile("" ::: "memory");
        if (tid == 0) { unsigned* c = cnt + 64 * ((row_off >> 8) + u.pm);
            (void)__hip_atomic_fetch_add(c, 1u, __ATOMIC_RELEASE, __HIP_MEMORY_SCOPE_AGENT);
            unsigned sp = 0; while (__hip_atomic_load(c, __ATOMIC_RELAXED, __HIP_MEMORY_SCOPE_AGENT) < 8u) { __builtin_amdgcn_s_sleep(1); if (++sp > (1u << 22)) break; }
            __builtin_amdgcn_fence(__ATOMIC_ACQUIRE, "agent");
            asm volatile("s_waitcnt vmcnt(0)" ::: "memory"); }
        __builtin_amdgcn_s_barrier(); asm volatile("" ::: "memory");
        float ry[8];
#pragma unroll
        for (int i = 0; i < 8; ++i) ry[i] = __hip_atomic_load(ssqY + prow + lrow + (i >> 2) * HALF + (i & 3) * 16, __ATOMIC_RELAXED, __HIP_MEMORY_SCOPE_AGENT);
        f32x4 gv[2][2];
#pragma unroll
        for (int bj = 0; bj < 2; ++bj) { gv[bj][0] = *(const f32x4*)(g + col0 + bj * HALF); gv[bj][1] = *(const f32x4*)(g + col0 + bj * HALF + 4); }
        asm volatile("s_waitcnt vmcnt(0)" ::: "memory");
#pragma unroll
        for (int i = 0; i < 8; ++i) ry[i] = rsqrtf(ry[i] * (1.f / DM) + EPS);
#pragma unroll
        for (int ai = 0; ai < 2; ++ai)
#pragma unroll
            for (int m = 0; m < 4; ++m) { const float r = ry[ai * 4 + m]; const size_t rowoff = (size_t)(prow + lrow + ai * HALF + m * 16) * DM + col0; float p2 = 0.f;
#pragma unroll
                for (int bj = 0; bj < 2; ++bj) { const size_t off = rowoff + bj * HALF;
                    f32x4 b0, b1;
                    if (BASE_F32) { b0 = *(const f32x4*)(baseF + off); b1 = *(const f32x4*)(baseF + off + 4); }
                    else { u32x4 w; if (m < 2) { w = bw[m][bj]; if (ai == 0) bw[m][bj] = *(const u32x4*)(HBio + off + (size_t)HALF * DM); } else w = *(const u32x4*)(HBio + off); b0 = (f32x4){bflo(w.x), bfhi(w.x), bflo(w.y), bfhi(w.y)}; b1 = (f32x4){bflo(w.z), bfhi(w.z), bflo(w.w), bfhi(w.w)}; }
                    const f32x4 h0 = b0 + acc[ai][bj][m][0] * r * gv[bj][0], h1 = b1 + acc[ai][bj][m][1] * r * gv[bj][1];
                    if (OUT_F32) { __builtin_nontemporal_store(h0, (f32x4*)(outF + off)); __builtin_nontemporal_store(h1, (f32x4*)(outF + off + 4)); }
                    else { p2 += (h0[0] * h0[0] + h0[1] * h0[1]) + (h0[2] * h0[2] + h0[3] * h0[3]) + (h1[0] * h1[0] + h1[1] * h1[1]) + (h1[2] * h1[2] + h1[3] * h1[3]);
                        u32x4 o; o.x = cvt_pk_bf16(h0[0], h0[1]); o.y = cvt_pk_bf16(h0[2], h0[3]); o.z = cvt_pk_bf16(h1[0], h1[1]); o.w = cvt_pk_bf16(h1[2], h1[3]); *(u32x4*)(HBio + off) = o; } }
                if (!OUT_F32) { p2 += __shfl_xor(p2, 16); p2 += __shfl_xor(p2, 32); if (fq == 0) P[(ai * HALF + wr * 64 + m * 16 + fr) * 4 + wc] = p2; }
                asm volatile("" ::: "memory"); }
        asm volatile("s_waitcnt lgkmcnt(0)" ::: "memory"); __builtin_amdgcn_s_barrier(); asm volatile("" ::: "memory");
        if (!OUT_F32) { if (tid < 256) { const float s = (P[tid * 4 + 0] + P[tid * 4 + 1]) + (P[tid * 4 + 2] + P[tid * 4 + 3]);
            (void)__hip_atomic_fetch_add(ssqH + prow + tid, s, __ATOMIC_RELAXED, __HIP_MEMORY_SCOPE_AGENT); } }
    }
};

constexpr int SHM_V = 16384, SHM_K = 24576, ATT_SCR = 2 * SHM_V + 2 * SHM_K;
__device__ __forceinline__ int v_st(int k, int c) { const int kk = (k & ~0xC) | ((k & 4) << 1) | ((k & 8) >> 1); return ((kk >> 3) * 4 + (c >> 5)) * 512 + ((kk & 7) * 32 + (c & 31)) * 2; }
__device__ __forceinline__ int v_rd_base(int lane) { return ((lane & 3) << 3) | (((lane >> 2) & 3) << 6) | (((lane >> 4) & 1) << 5) | (((lane >> 5) & 1) << 8); }
__device__ __forceinline__ int crow(int r, int hi) { return (r & 3) + 8 * (r >> 2) + 4 * hi; }
#define SBAR() __builtin_amdgcn_sched_barrier(0)

struct AttnArgs { const bf16_t* Q; int ldq; const bf16_t* Kn; int ldk; const bf16_t* Kp; const bf16_t* V; int ldv; bf16_t* O; int ldo; int ntiles; int cb; };

__device__ __forceinline__ void att_partialSM(f32x16& p0, f32x16& p1, float& m_reg, float& alpha) {
    float pmax = p0[0];
#pragma unroll
    for (int r = 1; r < 16; ++r) pmax = fmaxf(pmax, p0[r]);
#pragma unroll
    for (int r = 0; r < 16; ++r) pmax = fmaxf(pmax, p1[r]);
    { auto rr = __builtin_amdgcn_permlane32_swap(__float_as_uint(pmax), __float_as_uint(pmax), false, false);
      pmax = fmaxf(__uint_as_float(rr[0]), __uint_as_float(rr[1])); }
    float mn;
    if (__all((pmax - m_reg) <= 11.f)) { mn = m_reg; alpha = 1.f; }
    else { mn = fmaxf(m_reg, pmax); alpha = __builtin_amdgcn_exp2f(m_reg - mn); m_reg = mn; }
#pragma unroll
    for (int r = 0; r < 16; ++r) { p0[r] = __builtin_amdgcn_exp2f(p0[r] - mn); p1[r] = __builtin_amdgcn_exp2f(p1[r] - mn); }
}
__device__ __forceinline__ void att_finishSM(const f32x16& p0, const f32x16& p1, float alpha, float& l_reg, bf16x8& pa0, bf16x8& pa1, bf16x8& pa2, bf16x8& pa3) {
    float ps = 0.f;
#pragma unroll
    for (int r = 0; r < 16; ++r) ps += p0[r] + p1[r];
    { auto rr = __builtin_amdgcn_permlane32_swap(__float_as_uint(ps), __float_as_uint(ps), false, false);
      ps = __uint_as_float(rr[0]) + __uint_as_float(rr[1]); }
    l_reg = l_reg * alpha + ps;
#define PK4(P, B_, OUT) do { unsigned a0 = cvt_pk_bf16(P[B_+0], P[B_+1]), a1 = cvt_pk_bf16(P[B_+2], P[B_+3]);                          \
        unsigned b0 = cvt_pk_bf16(P[B_+4], P[B_+5]), b1 = cvt_pk_bf16(P[B_+6], P[B_+7]);                                             \
        auto r0 = __builtin_amdgcn_permlane32_swap(a0, b0, false, false); auto r1 = __builtin_amdgcn_permlane32_swap(a1, b1, false, false); \
        u32x4 w = {r0[0], r1[0], r0[1], r1[1]}; OUT = *reinterpret_cast<bf16x8*>(&w); } while (0)
    PK4(p0, 0, pa0); PK4(p0, 8, pa1); PK4(p1, 0, pa2); PK4(p1, 8, pa3);
#undef PK4
}
template <int KB, int NKC>
__device__ __forceinline__ void att_qkt(f32x16& p0, f32x16& p1, const char* K_lds, int r32, int hi, const bf16x8* qr) {
    p0 = f32x16{}; p1 = f32x16{};
    const int x = (r32 >> 1) & 7;
    const char* kb[4];
#pragma unroll
    for (int dd = 0; dd < 4; ++dd) kb[dd] = K_lds + KB * SHM_K + r32 * 128 + (((dd * 2 + hi) ^ x) << 4);
#pragma unroll
    for (int d0 = 0; d0 < NKC; ++d0) { const char* a = kb[d0 & 3] + (d0 >> 2) * 8192;
        const bf16x8 b0 = *reinterpret_cast<const bf16x8*>(a);
        const bf16x8 b1 = *reinterpret_cast<const bf16x8*>(a + 4096);
        p0 = __builtin_amdgcn_mfma_f32_32x32x16_bf16(b0, qr[d0], p0, 0, 0, 0);
        p1 = __builtin_amdgcn_mfma_f32_32x32x16_bf16(b1, qr[d0], p1, 0, 0, 0); }
}
template <int VB>
__device__ __forceinline__ void att_pv(f32x16* o, int vb0, bf16x8 pa0, bf16x8 pa1, bf16x8 pa2, bf16x8 pa3) {
#define TRRD(dst, off) asm volatile("ds_read_b64_tr_b16 %0, %1 offset:%2" : "=&v"(dst) : "v"(vb0), "i"(off) : "memory")
#define PV_D0(d0) do { s16x4 l0, l1, l2, l3, h0, h1, h2, h3; constexpr int b_ = VB * SHM_V + (d0) * 512; \
        TRRD(l0, b_); TRRD(h0, b_ + 2048); TRRD(l1, b_ + 4096); TRRD(h1, b_ + 6144); TRRD(l2, b_ + 8192); TRRD(h2, b_ + 10240); TRRD(l3, b_ + 12288); TRRD(h3, b_ + 14336); \
        asm volatile("s_waitcnt lgkmcnt(0)" ::: "memory"); SBAR(); \
        o[d0] = __builtin_amdgcn_mfma_f32_32x32x16_bf16(pa0, (bf16x8){l0[0], l0[1], l0[2], l0[3], h0[0], h0[1], h0[2], h0[3]}, o[d0], 0, 0, 0);   \
        o[d0] = __builtin_amdgcn_mfma_f32_32x32x16_bf16(pa1, (bf16x8){l1[0], l1[1], l1[2], l1[3], h1[0], h1[1], h1[2], h1[3]}, o[d0], 0, 0, 0);   \
        o[d0] = __builtin_amdgcn_mfma_f32_32x32x16_bf16(pa2, (bf16x8){l2[0], l2[1], l2[2], l2[3], h2[0], h2[1], h2[2], h2[3]}, o[d0], 0, 0, 0);   \
        o[d0] = __builtin_amdgcn_mfma_f32_32x32x16_bf16(pa3, (bf16x8){l3[0], l3[1], l3[2], l3[3], h3[0], h3[1], h3[2], h3[3]}, o[d0], 0, 0, 0); } while (0)
    PV_D0(0); PV_D0(1); PV_D0(2); PV_D0(3);
#undef PV_D0
#undef TRRD
}

template <int NKC>
__device__ __forceinline__ void attn_unit(const AttnArgs& a, char* lds) {
    constexpr bool PE = NKC > 8;
    int tid_ = threadIdx.x; asm volatile("" : "+v"(tid_));
    const int tid = tid_, wid = __builtin_amdgcn_readfirstlane(tid >> 6), lane = tid & 63, r32 = lane & 31, hi = lane >> 5;
    char* V_lds = lds; char* K_lds = lds + 2 * SHM_V;
    float* wsf = (float*)(lds + ATT_SCR) + wid * 64; float* li_l = wsf; float* al_l = wsf + 32;
    const int sr = tid >> 4, c16 = tid & 15, sc = c16 * 8;
    const int vst0 = v_st(sr, sc), vst1 = v_st(32 + sr, sc);
    const int kws = (c16 >> 3) * 8192 + sr * 128 + (((c16 & 7) ^ ((sr >> 1) & 7)) << 4);
    const int pkey = tid >> 3, pws = 16384 + pkey * 128 + (((tid & 7) ^ ((pkey >> 1) & 7)) << 4);
    const int vb0 = (int)(uintptr_t)V_lds + v_rd_base(lane);
    const int mytiles = min(a.ntiles, a.cb + (wid >> 1) + 1);
    bf16x8 qr[NKC];
#pragma unroll
    for (int d0 = 0; d0 < NKC; ++d0) qr[d0] = *(const bf16x8*)(a.Q + (size_t)(wid * 32 + r32) * a.ldq + d0 * 16 + hi * 8);
    bf16x8 st_k0, st_k1, st_v0, st_v1, st_p;
#define ALOAD(t) do { const size_t k0_ = (size_t)(t) * 64; \
        st_k0 = *(const bf16x8*)(a.Kn + (k0_ + sr) * a.ldk + sc); st_k1 = *(const bf16x8*)(a.Kn + (k0_ + 32 + sr) * a.ldk + sc); \
        st_v0 = *(const bf16x8*)(a.V + (k0_ + sr) * a.ldv + sc); st_v1 = *(const bf16x8*)(a.V + (k0_ + 32 + sr) * a.ldv + sc); \
        if constexpr (PE) st_p = *(const bf16x8*)(a.Kp + (k0_ + pkey) * 64 + (tid & 7) * 8); } while (0)
#define AWRITE(bf) do { *(bf16x8*)(K_lds + (bf) * SHM_K + kws) = st_k0; *(bf16x8*)(K_lds + (bf) * SHM_K + kws + 4096) = st_k1; \
        *(bf16x8*)(V_lds + (bf) * SHM_V + vst0) = st_v0; *(bf16x8*)(V_lds + (bf) * SHM_V + vst1) = st_v1; \
        if constexpr (PE) *(bf16x8*)(K_lds + (bf) * SHM_K + pws) = st_p; } while (0)
    float m_reg = -1e30f, l_reg = 0.f; f32x16 o[4] = {};
    ALOAD(0); AWRITE(0);
    __syncthreads();
#define ATILE(t, BF) do { \
        if ((t) + 1 < a.ntiles) ALOAD((t) + 1); \
        if ((t) < mytiles) { f32x16 p0, p1; float alpha; bf16x8 pa0, pa1, pa2, pa3; \
            att_qkt<BF, NKC>(p0, p1, K_lds, r32, hi, qr); \
            att_partialSM(p0, p1, m_reg, alpha); \
            if (__any(alpha < 1.f)) { if (hi == 0) al_l[r32] = alpha; asm volatile("s_waitcnt lgkmcnt(0)" ::: "memory"); \
                _Pragma("unroll") for (int d_ = 0; d_ < 4; ++d_) _Pragma("unroll") for (int r = 0; r < 16; ++r) o[d_][r] *= al_l[crow(r, hi)]; } \
            att_finishSM(p0, p1, alpha, l_reg, pa0, pa1, pa2, pa3); SBAR(); \
            att_pv<BF>(o, vb0, pa0, pa1, pa2, pa3); } \
        if ((t) + 1 < a.ntiles) AWRITE(1 - (BF)); \
        __syncthreads(); } while (0)
    for (int t = 0; t < a.ntiles; t += 2) {
        ATILE(t, 0);
        if (t + 1 < a.ntiles) ATILE(t + 1, 1);
    }
#undef ATILE
#undef ALOAD
#undef AWRITE
    if (hi == 0) li_l[r32] = l_reg; asm volatile("s_waitcnt lgkmcnt(0)" ::: "memory");
    float rli[16];
#pragma unroll
    for (int r = 0; r < 16; ++r) rli[r] = __builtin_amdgcn_rcpf(li_l[crow(r, hi)]);
    bf16_t* Ow = a.O + (size_t)(wid * 32) * a.ldo;
#pragma unroll
    for (int r = 0; r < 16; ++r) { const int orow = crow(r, hi);
#pragma unroll
        for (int d0 = 0; d0 < 4; ++d0) { const float v = o[d0][r] * rli[r];
            const float vn = __shfl_xor(v, 1);
            if ((r32 & 1) == 0) *(unsigned*)(Ow + (size_t)orow * a.ldo + d0 * 32 + r32) = cvt_pk_bf16(v, vn); } }
    __syncthreads();
}

#define XB_TMO      128
#define XB_XCNT(j)  (256  + 64 * (j))
#define XB_XSUB(j)  (1280 + 64 * (j))
#define XB_XGEN(j)  (2304 + 64 * (j))
#define XB_TOP      3328
#define XB_TOPGEN   3392
#define XCD_BAR_WORDS 3456
#define XB_SPIN_CAP (1u << 18)

__device__ __forceinline__ unsigned xb_ld(unsigned* p)              { return __hip_atomic_load(p, __ATOMIC_RELAXED, __HIP_MEMORY_SCOPE_AGENT); }
__device__ __forceinline__ unsigned xb_add(unsigned* p, unsigned v) { return __hip_atomic_fetch_add(p, v, __ATOMIC_RELAXED, __HIP_MEMORY_SCOPE_AGENT); }
__device__ __forceinline__ unsigned xb_xcc_id() { return (unsigned)__builtin_amdgcn_s_getreg((3 << 11) | 20) & 0xFu; }
#define XB_SPIN(cond, bar) do { unsigned _sp = 0; while (cond) { __builtin_amdgcn_s_sleep(1); \
    if ((++_sp & 255u) == 0u) { if (xb_ld(&(bar)[XB_TMO])) break; if (_sp > XB_SPIN_CAP) { atomicAdd(&(bar)[XB_TMO], 1u); break; } } } } while (0)

struct XcdBarrier {
    unsigned* bar; unsigned x;
    volatile LAS unsigned* st;
};

__device__ __forceinline__ XcdBarrier xcd_barrier_post(unsigned* bar, volatile LAS unsigned* st) {
    XcdBarrier b; b.bar = bar; b.x = xb_xcc_id(); b.st = st;
    if (threadIdx.x == 0) (void)xb_add(&bar[XB_XCNT(b.x)], 1u);
    return b;
}
__device__ __forceinline__ void xcd_barrier_complete(unsigned* bar, unsigned x, unsigned& nloc, unsigned& nx) {
    const unsigned G = gridDim.x * gridDim.y * gridDim.z;
    unsigned sum, cnt, mine, sp = 0u;
    for (;;) {
        sum = 0u; cnt = 0u; mine = 0u;
#pragma unroll
        for (unsigned j = 0; j < 16; ++j) { const unsigned c = xb_ld(&bar[XB_XCNT(j)]); sum += c; cnt += (c > 0u) ? 1u : 0u; mine = (j == x) ? c : mine; }
        if (sum == G) break;
        __builtin_amdgcn_s_sleep(1);
        if ((++sp & 255u) == 0u) { if (xb_ld(&bar[XB_TMO])) break; if (sp > XB_SPIN_CAP) { atomicAdd(&bar[XB_TMO], 1u); break; } }
    }
    nloc = mine > 0u ? mine : 1u; nx = cnt > 0u ? cnt : 1u;
}

__device__ __forceinline__ void xcd_barrier(const XcdBarrier& b) {
    asm volatile("s_waitcnt vmcnt(0)" ::: "memory");
    __syncthreads();
    if (threadIdx.x == 0) {
        unsigned* bar = b.bar;
        __builtin_amdgcn_s_waitcnt(0);
        unsigned nloc = b.st[0], nx = b.st[1];
        if (nloc == 0u) { xcd_barrier_complete(bar, b.x, nloc, nx); b.st[0] = nloc; b.st[1] = nx; }
        const unsigned old = xb_add(&bar[XB_XSUB(b.x)], 1u);
        const unsigned gen = old / nloc;
        if (old + 1u == (gen + 1u) * nloc) {
            __builtin_amdgcn_fence(__ATOMIC_RELEASE, "agent");
            asm volatile("s_waitcnt vmcnt(0)" ::: "memory");
            const unsigned og = xb_add(&bar[XB_TOP], 1u);
            const unsigned tg = og / nx;
            if (og + 1u == (tg + 1u) * nx) xb_add(&bar[XB_TOPGEN], 1u);
            else XB_SPIN(xb_ld(&bar[XB_TOPGEN]) == tg, bar);
            __builtin_amdgcn_fence(__ATOMIC_ACQUIRE, "agent");
            xb_add(&bar[XB_XGEN(b.x)], 1u);
            asm volatile("s_waitcnt vmcnt(0)" ::: "memory");
        } else {
            XB_SPIN(xb_ld(&bar[XB_XGEN(b.x)]) == gen, bar);
            __builtin_amdgcn_fence(__ATOMIC_ACQUIRE, "agent");
            asm volatile("s_waitcnt vmcnt(0)" ::: "memory");
        }
    }
    __syncthreads();
}

constexpr int ATT_SLOTS = 8;
__device__ const unsigned short g_att_sched[256][ATT_SLOTS] = {
{15,518,512,1056,1200,65535,65535,65535},
{31,534,528,1057,1201,65535,65535,65535},
{47,550,544,1058,1202,65535,65535,65535},
{63,566,560,1059,1203,65535,65535,65535},
{79,582,576,1060,1204,65535,65535,65535},
{95,598,592,1061,1205,65535,65535,65535},
{111,614,608,1062,1206,65535,65535,65535},
{127,630,624,1063,1207,65535,65535,65535},
{143,646,640,1064,1208,65535,65535,65535},
{159,662,656,1065,1209,65535,65535,65535},
{175,678,672,1066,1210,65535,65535,65535},
{191,694,688,1067,1211,65535,65535,65535},
{207,710,704,1068,1212,65535,65535,65535},
{223,726,720,1069,1213,65535,65535,65535},
{239,742,736,1070,1214,65535,65535,65535},
{255,758,752,1071,1215,65535,65535,65535},
{271,5,514,1152,65535,65535,65535,65535},
{287,21,530,1153,65535,65535,65535,65535},
{303,37,546,1154,65535,65535,65535,65535},
{319,53,562,1155,65535,65535,65535,65535},
{335,69,578,1156,65535,65535,65535,65535},
{351,85,594,1157,65535,65535,65535,65535},
{367,101,610,1158,65535,65535,65535,65535},
{383,117,626,1159,65535,65535,65535,65535},
{399,133,642,1160,65535,65535,65535,65535},
{415,149,658,1161,65535,65535,65535,65535},
{431,165,674,1162,65535,65535,65535,65535},
{447,181,690,1163,65535,65535,65535,65535},
{463,197,706,1164,65535,65535,65535,65535},
{479,213,722,1165,65535,65535,65535,65535},
{495,229,738,1166,65535,65535,65535,65535},
{511,245,754,1167,65535,65535,65535,65535},
{527,261,1,1072,1216,65535,65535,65535},
{543,277,17,1073,1217,65535,65535,65535},
{559,293,33,1074,1218,65535,65535,65535},
{575,309,49,1075,1219,65535,65535,65535},
{591,325,65,1076,1220,65535,65535,65535},
{607,341,81,1077,1221,65535,65535,65535},
{623,357,97,1078,1222,65535,65535,65535},
{639,373,113,1079,1223,65535,65535,65535},
{655,389,129,1080,1224,65535,65535,65535},
{671,405,145,1081,1225,65535,65535,65535},
{687,421,161,1082,1226,65535,65535,65535},
{703,437,177,1083,1227,65535,65535,65535},
{719,453,193,1084,1228,65535,65535,65535},
{735,469,209,1085,1229,65535,65535,65535},
{751,485,225,1086,1230,65535,65535,65535},
{767,501,241,1087,1231,65535,65535,65535},
{14,519,257,1088,65535,65535,65535,65535},
{30,535,273,1089,65535,65535,65535,65535},
{46,551,289,1090,65535,65535,65535,65535},
{62,567,305,1091,65535,65535,65535,65535},
{78,583,321,1092,65535,65535,65535,65535},
{94,599,337,1093,65535,65535,65535,65535},
{110,615,353,1094,65535,65535,65535,65535},
{126,631,369,1095,65535,65535,65535,65535},
{142,647,385,1096,65535,65535,65535,65535},
{158,663,401,1097,65535,65535,65535,65535},
{174,679,417,1098,65535,65535,65535,65535},
{190,695,433,1099,65535,65535,65535,65535},
{206,711,449,1100,65535,65535,65535,65535},
{222,727,465,1101,65535,65535,65535,65535},
{238,743,481,1102,65535,65535,65535,65535},
{254,759,497,1103,65535,65535,65535,65535},
{13,6,517,65535,65535,65535,65535,65535},
{29,22,533,65535,65535,65535,65535,65535},
{45,38,549,65535,65535,65535,65535,65535},
{61,54,565,65535,65535,65535,65535,65535},
{77,70,581,65535,65535,65535,65535,65535},
{93,86,597,65535,65535,65535,65535,65535},
{109,102,613,65535,65535,65535,65535,65535},
{125,118,629,65535,65535,65535,65535,65535},
{141,134,645,65535,65535,65535,65535,65535},
{157,150,661,65535,65535,65535,65535,65535},
{173,166,677,65535,65535,65535,65535,65535},
{189,182,693,65535,65535,65535,65535,65535},
{205,198,709,65535,65535,65535,65535,65535},
{221,214,725,65535,65535,65535,65535,65535},
{237,230,741,65535,65535,65535,65535,65535},
{253,246,757,65535,65535,65535,65535,65535},
{526,262,4,65535,65535,65535,65535,65535},
{542,278,20,65535,65535,65535,65535,65535},
{558,294,36,65535,65535,65535,65535,65535},
{574,310,52,65535,65535,65535,65535,65535},
{590,326,68,65535,65535,65535,65535,65535},
{606,342,84,65535,65535,65535,65535,65535},
{622,358,100,65535,65535,65535,65535,65535},
{638,374,116,65535,65535,65535,65535,65535},
{654,390,132,65535,65535,65535,65535,65535},
{670,406,148,65535,65535,65535,65535,65535},
{686,422,164,65535,65535,65535,65535,65535},
{702,438,180,65535,65535,65535,65535,65535},
{718,454,196,65535,65535,65535,65535,65535},
{734,470,212,65535,65535,65535,65535,65535},
{750,486,228,65535,65535,65535,65535,65535},
{766,502,244,65535,65535,65535,65535,65535},
{270,520,513,1104,65535,65535,65535,65535},
{286,536,529,1105,65535,65535,65535,65535},
{302,552,545,1106,65535,65535,65535,65535},
{318,568,561,1107,65535,65535,65535,65535},
{334,584,577,1108,65535,65535,65535,65535},
{350,600,593,1109,65535,65535,65535,65535},
{366,616,609,1110,65535,65535,65535,65535},
{382,632,625,1111,65535,65535,65535,65535},
{398,648,641,1112,65535,65535,65535,65535},
{414,664,657,1113,65535,65535,65535,65535},
{430,680,673,1114,65535,65535,65535,65535},
{446,696,689,1115,65535,65535,65535,65535},
{462,712,705,1116,65535,65535,65535,65535},
{478,728,721,1117,65535,65535,65535,65535},
{494,744,737,1118,65535,65535,65535,65535},
{510,760,753,1119,65535,65535,65535,65535},
{269,7,260,65535,65535,65535,65535,65535},
{285,23,276,65535,65535,65535,65535,65535},
{301,39,292,65535,65535,65535,65535,65535},
{317,55,308,65535,65535,65535,65535,65535},
{333,71,324,65535,65535,65535,65535,65535},
{349,87,340,65535,65535,65535,65535,65535},
{365,103,356,65535,65535,65535,65535,65535},
{381,119,372,65535,65535,65535,65535,65535},
{397,135,388,65535,65535,65535,65535,65535},
{413,151,404,65535,65535,65535,65535,65535},
{429,167,420,65535,65535,65535,65535,65535},
{445,183,436,65535,65535,65535,65535,65535},
{461,199,452,65535,65535,65535,65535,65535},
{477,215,468,65535,65535,65535,65535,65535},
{493,231,484,65535,65535,65535,65535,65535},
{509,247,500,65535,65535,65535,65535,65535},
{525,263,516,65535,65535,65535,65535,65535},
{541,279,532,65535,65535,65535,65535,65535},
{557,295,548,65535,65535,65535,65535,65535},
{573,311,564,65535,65535,65535,65535,65535},
{589,327,580,65535,65535,65535,65535,65535},
{605,343,596,65535,65535,65535,65535,65535},
{621,359,612,65535,65535,65535,65535,65535},
{637,375,628,65535,65535,65535,65535,65535},
{653,391,644,65535,65535,65535,65535,65535},
{669,407,660,65535,65535,65535,65535,65535},
{685,423,676,65535,65535,65535,65535,65535},
{701,439,692,65535,65535,65535,65535,65535},
{717,455,708,65535,65535,65535,65535,65535},
{733,471,724,65535,65535,65535,65535,65535},
{749,487,740,65535,65535,65535,65535,65535},
{765,503,756,65535,65535,65535,65535,65535},
{12,521,0,1024,1168,65535,65535,65535},
{28,537,16,1025,1169,65535,65535,65535},
{44,553,32,1026,1170,65535,65535,65535},
{60,569,48,1027,1171,65535,65535,65535},
{76,585,64,1028,1172,65535,65535,65535},
{92,601,80,1029,1173,65535,65535,65535},
{108,617,96,1030,1174,65535,65535,65535},
{124,633,112,1031,1175,65535,65535,65535},
{140,649,128,1032,1176,65535,65535,65535},
{156,665,144,1033,1177,65535,65535,65535},
{172,681,160,1034,1178,65535,65535,65535},
{188,697,176,1035,1179,65535,65535,65535},
{204,713,192,1036,1180,65535,65535,65535},
{220,729,208,1037,1181,65535,65535,65535},
{236,745,224,1038,1182,65535,65535,65535},
{252,761,240,1039,1183,65535,65535,65535},
{268,8,3,1232,65535,65535,65535,65535},
{284,24,19,1233,65535,65535,65535,65535},
{300,40,35,1234,65535,65535,65535,65535},
{316,56,51,1235,65535,65535,65535,65535},
{332,72,67,1236,65535,65535,65535,65535},
{348,88,83,1237,65535,65535,65535,65535},
{364,104,99,1238,65535,65535,65535,65535},
{380,120,115,1239,65535,65535,65535,65535},
{396,136,131,1240,65535,65535,65535,65535},
{412,152,147,1241,65535,65535,65535,65535},
{428,168,163,1242,65535,65535,65535,65535},
{444,184,179,1243,65535,65535,65535,65535},
{460,200,195,1244,65535,65535,65535,65535},
{476,216,211,1245,65535,65535,65535,65535},
{492,232,227,1246,65535,65535,65535,65535},
{508,248,243,1247,65535,65535,65535,65535},
{524,264,259,1248,65535,65535,65535,65535},
{540,280,275,1249,65535,65535,65535,65535},
{556,296,291,1250,65535,65535,65535,65535},
{572,312,307,1251,65535,65535,65535,65535},
{588,328,323,1252,65535,65535,65535,65535},
{604,344,339,1253,65535,65535,65535,65535},
{620,360,355,1254,65535,65535,65535,65535},
{636,376,371,1255,65535,65535,65535,65535},
{652,392,387,1256,65535,65535,65535,65535},
{668,408,403,1257,65535,65535,65535,65535},
{684,424,419,1258,65535,65535,65535,65535},
{700,440,435,1259,65535,65535,65535,65535},
{716,456,451,1260,65535,65535,65535,65535},
{732,472,467,1261,65535,65535,65535,65535},
{748,488,483,1262,65535,65535,65535,65535},
{764,504,499,1263,65535,65535,65535,65535},
{11,522,256,1040,1184,65535,65535,65535},
{27,538,272,1041,1185,65535,65535,65535},
{43,554,288,1042,1186,65535,65535,65535},
{59,570,304,1043,1187,65535,65535,65535},
{75,586,320,1044,1188,65535,65535,65535},
{91,602,336,1045,1189,65535,65535,65535},
{107,618,352,1046,1190,65535,65535,65535},
{123,634,368,1047,1191,65535,65535,65535},
{139,650,384,1048,1192,65535,65535,65535},
{155,666,400,1049,1193,65535,65535,65535},
{171,682,416,1050,1194,65535,65535,65535},
{187,698,432,1051,1195,65535,65535,65535},
{203,714,448,1052,1196,65535,65535,65535},
{219,730,464,1053,1197,65535,65535,65535},
{235,746,480,1054,1198,65535,65535,65535},
{251,762,496,1055,1199,65535,65535,65535},
{267,9,515,1264,65535,65535,65535,65535},
{283,25,531,1265,65535,65535,65535,65535},
{299,41,547,1266,65535,65535,65535,65535},
{315,57,563,1267,65535,65535,65535,65535},
{331,73,579,1268,65535,65535,65535,65535},
{347,89,595,1269,65535,65535,65535,65535},
{363,105,611,1270,65535,65535,65535,65535},
{379,121,627,1271,65535,65535,65535,65535},
{395,137,643,1272,65535,65535,65535,65535},
{411,153,659,1273,65535,65535,65535,65535},
{427,169,675,1274,65535,65535,65535,65535},
{443,185,691,1275,65535,65535,65535,65535},
{459,201,707,1276,65535,65535,65535,65535},
{475,217,723,1277,65535,65535,65535,65535},
{491,233,739,1278,65535,65535,65535,65535},
{507,249,755,1279,65535,65535,65535,65535},
{523,265,2,1120,65535,65535,65535,65535},
{539,281,18,1121,65535,65535,65535,65535},
{555,297,34,1122,65535,65535,65535,65535},
{571,313,50,1123,65535,65535,65535,65535},
{587,329,66,1124,65535,65535,65535,65535},
{603,345,82,1125,65535,65535,65535,65535},
{619,361,98,1126,65535,65535,65535,65535},
{635,377,114,1127,65535,65535,65535,65535},
{651,393,130,1128,65535,65535,65535,65535},
{667,409,146,1129,65535,65535,65535,65535},
{683,425,162,1130,65535,65535,65535,65535},
{699,441,178,1131,65535,65535,65535,65535},
{715,457,194,1132,65535,65535,65535,65535},
{731,473,210,1133,65535,65535,65535,65535},
{747,489,226,1134,65535,65535,65535,65535},
{763,505,242,1135,65535,65535,65535,65535},
{10,266,258,1136,65535,65535,65535,65535},
{26,282,274,1137,65535,65535,65535,65535},
{42,298,290,1138,65535,65535,65535,65535},
{58,314,306,1139,65535,65535,65535,65535},
{74,330,322,1140,65535,65535,65535,65535},
{90,346,338,1141,65535,65535,65535,65535},
{106,362,354,1142,65535,65535,65535,65535},
{122,378,370,1143,65535,65535,65535,65535},
{138,394,386,1144,65535,65535,65535,65535},
{154,410,402,1145,65535,65535,65535,65535},
{170,426,418,1146,65535,65535,65535,65535},
{186,442,434,1147,65535,65535,65535,65535},
{202,458,450,1148,65535,65535,65535,65535},
{218,474,466,1149,65535,65535,65535,65535},
{234,490,482,1150,65535,65535,65535,65535},
{250,506,498,1151,65535,65535,65535,65535}};

struct Args {
    const float *x, *mem; const int* pos;
    const float *g_mix_pre, *g_mix_post, *g_mlp_pre, *g_mlp_post, *g_mem, *w_mem_k, *w_mem_v, *w_o, *w_ff1, *w_ff2;
    const float *a_w_in, *a_conv_w, *a_conv_b, *a_w_r, *a_b_r, *a_w_i, *a_b_i, *a_lambda;
    const float *b_w_in, *b_g_qa, *b_w_qb, *kv_g_in, *kv_w_down, *kv_g_latent, *kv_w_up;
    float* out; unsigned char* ws;
    float invf[32];
    int ph_lo, ph_hi;
};

__device__ __forceinline__ int rope_pos(int j) { return 32 * ((j >> 4) & 1) + 16 * (j >> 5) + (j & 15); }
__device__ __forceinline__ void tr_load(const float* W, int ldw, int scol0, int ncols, int item, int lane, float (&v)[32]) {
    const int nblk = ncols / 32, kb = item / nblk, nb = item - kb * nblk, k0 = 64 * kb, n0 = 32 * nb;
    const float* wp = W + (size_t)(k0 + (lane >> 5)) * ldw + scol0 + n0 + (lane & 31);
#pragma unroll
    for (int i = 0; i < 32; ++i) v[i] = __builtin_nontemporal_load(wp + (size_t)(2 * i) * ldw);
}
__device__ __forceinline__ void tr_store(const float (&v)[32], int ncols, const float* gain, bf16_t* WT, int ldk, int koff, int kind, int rbase, LAS float* scr, int item, int lane, bool far = false) {
    const int nblk = ncols / 32, kb = item / nblk, nb = item - kb * nblk, k0 = 64 * kb, n0 = 32 * nb;
    const int c = lane & 7;
    f32x4 g0 = {1.f, 1.f, 1.f, 1.f}, g1 = g0;
    if (gain) { g0 = *(const f32x4*)(gain + k0 + 8 * c); g1 = *(const f32x4*)(gain + k0 + 8 * c + 4); }
#pragma unroll
    for (int i = 0; i < 32; ++i) scr[(2 * i + (lane >> 5)) * 33 + (lane & 31)] = v[i];
    asm volatile("s_waitcnt lgkmcnt(0)" ::: "memory");
#pragma unroll
    for (int j = 0; j < 4; ++j) { const int n = (lane >> 3) + 8 * j; const LAS float* s = scr + (8 * c) * 33 + n;
        u32x4 o; o.x = cvt_pk_bf16(s[0 * 33] * g0[0], s[1 * 33] * g0[1]); o.y = cvt_pk_bf16(s[2 * 33] * g0[2], s[3 * 33] * g0[3]);
        o.z = cvt_pk_bf16(s[4 * 33] * g1[0], s[5 * 33] * g1[1]); o.w = cvt_pk_bf16(s[6 * 33] * g1[2], s[7 * 33] * g1[3]);
        const int nn = n0 + n; int drow;
        if (kind == 0) drow = rbase + nn;
        else if (kind == 1) { const int head = nn / 192, w = nn - head * 192; drow = head * 192 + (w >= 128 ? 128 + rope_pos(w - 128) : w); }
        else drow = rbase + rope_pos(nn);
        if (far) __builtin_nontemporal_store(o, (u32x4*)(WT + (size_t)drow * ldk + koff + k0 + 8 * c)); else *(u32x4*)(WT + (size_t)drow * ldk + koff + k0 + 8 * c) = o; }
    asm volatile("s_waitcnt lgkmcnt(0)" ::: "memory");
}
__device__ __forceinline__ void tr_job(int& it, int stride, const float* W, int ldw, int scol0, int ncols, int K, const float* gain, bf16_t* WT, int ldk, int koff, int kind, int rbase, LAS float* scr, int lane, bool far = false) {
    const int ni = (K / 64) * (ncols / 32);
    if (it < ni) { float v[32]; tr_load(W, ldw, scol0, ncols, it, lane, v);
        for (;;) { const int nx = it + stride; float w[32];
            if (nx < ni) tr_load(W, ldw, scol0, ncols, nx, lane, w);
            tr_store(v, ncols, gain, WT, ldk, koff, kind, rbase, scr, it, lane, far);
            it = nx; if (nx >= ni) break;
#pragma unroll
            for (int i = 0; i < 32; ++i) v[i] = w[i]; } }
    it -= ni;
}
__device__ __forceinline__ void cvt_rows(const float* src, bf16_t* dst, float* rstd, int nrows, int gw, int NGW, int lane) {
    for (int row = gw; row < nrows; row += NGW) {
        const float* xr = src + (size_t)row * DM; float ss = 0.f;
#pragma unroll
        for (int j = 0; j < 4; ++j) { const int col = (lane + 64 * j) * 8; const f32x4 a = __builtin_nontemporal_load((const f32x4*)(xr + col)), b = __builtin_nontemporal_load((const f32x4*)(xr + col + 4));
            ss += (a[0] * a[0] + a[1] * a[1]) + (a[2] * a[2] + a[3] * a[3]) + (b[0] * b[0] + b[1] * b[1]) + (b[2] * b[2] + b[3] * b[3]);
            u32x4 w; w.x = cvt_pk_bf16(a[0], a[1]); w.y = cvt_pk_bf16(a[2], a[3]); w.z = cvt_pk_bf16(b[0], b[1]); w.w = cvt_pk_bf16(b[2], b[3]);
            *(u32x4*)(dst + (size_t)row * DM + col) = w; }
        ss = wave_sum(ss);
        if (lane == 0) rstd[row] = rsqrtf(ss * (1.f / DM) + EPS);
    }
}
template <bool BASE_F32, bool OUT_F32>
__device__ __forceinline__ void row_pass(const bf16_t* Y, const float* baseF, const float* g, float* outF, bf16_t* HBio, float* rstd_out, int gw, int NGW, int lane) {
    for (int row = gw; row < T; row += NGW) {
        const u32x4* yr = (const u32x4*)(Y + (size_t)row * DM) + lane;
        u32x4 yw[4]; u32x4 bw[4]; float ss = 0.f;
#pragma unroll
        for (int j = 0; j < 4; ++j) yw[j] = yr[64 * j];
        if (!BASE_F32) {
#pragma unroll
            for (int j = 0; j < 4; ++j) bw[j] = ((const u32x4*)(HBio + (size_t)row * DM) + lane)[64 * j]; }
#pragma unroll
        for (int j = 0; j < 4; ++j) { const u32x4 w = yw[j];
            ss += bflo(w.x) * bflo(w.x) + bfhi(w.x) * bfhi(w.x) + bflo(w.y) * bflo(w.y) + bfhi(w.y) * bfhi(w.y) + bflo(w.z) * bflo(w.z) + bfhi(w.z) * bfhi(w.z) + bflo(w.w) * bflo(w.w) + bfhi(w.w) * bfhi(w.w); }
        ss = wave_sum(ss);
        const float ry = rsqrtf(ss * (1.f / DM) + EPS); float ss2 = 0.f;
#pragma unroll
        for (int j = 0; j < 4; ++j) { const int col = (lane + 64 * j) * 8; const size_t off = (size_t)row * DM + col;
            f32x4 b0, b1;
            if (BASE_F32) { b0 = *(const f32x4*)(baseF + off); b1 = *(const f32x4*)(baseF + off + 4); }
            else { const u32x4 w = bw[j]; b0 = (f32x4){bflo(w.x), bfhi(w.x), bflo(w.y), bfhi(w.y)}; b1 = (f32x4){bflo(w.z), bfhi(w.z), bflo(w.w), bfhi(w.w)}; }
            const f32x4 g0 = *(const f32x4*)(g + col), g1 = *(const f32x4*)(g + col + 4);
            const u32x4 w = yw[j];
            const f32x4 y0 = {bflo(w.x), bfhi(w.x), bflo(w.y), bfhi(w.y)}, y1 = {bflo(w.z), bfhi(w.z), bflo(w.w), bfhi(w.w)};
            const f32x4 h0 = b0 + y0 * ry * g0, h1 = b1 + y1 * ry * g1;
            if (OUT_F32) { *(f32x4*)(outF + off) = h0; *(f32x4*)(outF + off + 4) = h1; }
            else { ss2 += (h0[0] * h0[0] + h0[1] * h0[1]) + (h0[2] * h0[2] + h0[3] * h0[3]) + (h1[0] * h1[0] + h1[1] * h1[1]) + (h1[2] * h1[2] + h1[3] * h1[3]);
                u32x4 o; o.x = cvt_pk_bf16(h0[0], h0[1]); o.y = cvt_pk_bf16(h0[2], h0[3]); o.z = cvt_pk_bf16(h1[0], h1[1]); o.w = cvt_pk_bf16(h1[2], h1[3]); *(u32x4*)(HBio + off) = o; } }
        if (!OUT_F32) { ss2 = wave_sum(ss2); if (lane == 0) rstd_out[row] = rsqrtf(ss2 * (1.f / DM) + EPS); }
    }
}

constexpr int LDS_BYTES = 147456;
constexpr int NPH = 21;

#ifndef PHMASK
#define PHMASK 0xffffffffu
#endif
typedef const __attribute__((address_space(4))) Args* ArgsP;
#define PHASE_BEGIN ArgsP ap = (ArgsP)__builtin_amdgcn_kernarg_segment_ptr(); asm volatile("" : "+s"(ap) :: "memory"); unsigned char* ws = ap->ws; \
    int tid_ = threadIdx.x, bx_ = blockIdx.x; asm volatile("" : "+v"(tid_), "+s"(bx_)); const int tid = tid_, lane = tid & 63, wave = __builtin_amdgcn_readfirstlane(tid >> 6); const int G = gridDim.x, bx = bx_; \
    const int gw = bx * 8 + wave, NGW = G * 8, gt = bx * 512 + tid, NGT = G * 512; (void)lane; (void)gw; (void)NGW; (void)gt; (void)NGT; (void)ws;
using SO = pg8::StaticOrder;
using EN_TF = EpiNorm<true, false>; using EN_FF = EpiNorm<false, false>; using EN_FT = EpiNorm<false, true>;
#define RUN_GEMM(EPI, e, A_, B_, lda_, ldb_, K_, M_, N_, cidx) do { pg8::Gemm g_{A_, B_, lda_, ldb_, K_, 0, 0}; SO S_; S_.init(M_, N_, G, cidx); \
        pg8::gemm_phase<EPI, SO, true, true>(ldsl, g_, S_, e); } while (0)
#define WSP(T_, off) ((T_*)(ws + (off)))

__global__ void __launch_bounds__(512, 2) fwd_mega(Args args_unused) {
    extern __shared__ __attribute__((aligned(16))) unsigned char lds[];
    LAS unsigned char* ldsl = (LAS unsigned char*)lds;
    volatile LAS unsigned* bst = (volatile LAS unsigned*)(ldsl + 131072 + 64);
    if (threadIdx.x < 4) bst[threadIdx.x] = 0u;
    __syncthreads();
    { ArgsP ap0 = (ArgsP)__builtin_amdgcn_kernarg_segment_ptr(); (void)xcd_barrier_post((unsigned*)(ap0->ws + WS_BAR), bst); }
#define SEAM() do { ArgsP apb_ = (ArgsP)__builtin_amdgcn_kernarg_segment_ptr(); asm volatile("" : "+s"(apb_) :: "memory"); XcdBarrier b_; b_.bar = (unsigned*)(apb_->ws + WS_BAR); b_.x = xb_xcc_id(); b_.st = bst; xcd_barrier(b_); } while (0)

    if ((PHMASK >> 0) & 1) { PHASE_BEGIN
        float* ssq_cq = WSP(float, WS_SSQCQ); float* ssq_lat = WSP(float, WS_SSQLAT); float* cosT = WSP(float, WS_COS); float* sinT = WSP(float, WS_SIN);
        for (int i = gt; i < T; i += NGT) { ssq_cq[i] = 0.f; ssq_lat[i] = 0.f; }
        for (int i = gt; i < (int)((WS_CTL_ZERO_END - WS_SSQY) / 4); i += NGT) ((unsigned*)(ws + WS_SSQY))[i] = 0u;
        { const int* pos = ap->pos;
        for (int i = gt; i < T * 32; i += NGT) { const int t = i >> 5, f = i & 31; const float ang = (float)pos[t] * ap->invf[f];
            double rev = (double)ang * 0.15915494309189535; rev -= rint(rev); const float rf = (float)rev;
            cosT[i] = __builtin_amdgcn_cosf(rf); sinT[i] = __builtin_amdgcn_sinf(rf); } }
        { u32x4 z = {0u, 0u, 0u, 0u};
          u32x4* p = (u32x4*)(ws + WS_WBIN + (size_t)1856 * 2048 * 2); for (int i = gt; i < 192 * 2048 * 2 / 16; i += NGT) p[i] = z;
          for (int i = gt; i < 3072 * 16; i += NGT) { const int row = i >> 4, c = i & 15; const int pnr = (row >> 8) & 1;
              *(u32x4*)(ws + WS_WGATE + ((size_t)row * 256 + (1 - pnr) * 128) * 2 + c * 16) = z; } }
        cvt_rows(ap->x, WSP(bf16_t, WS_HB), WSP(float, WS_RSTD), T, gw, NGW, lane);
        cvt_rows(ap->mem, WSP(bf16_t, WS_MEMB), WSP(float, WS_RSTDMEM), 1024, gw, NGW, lane);
        LAS float* scr = (LAS float*)(ldsl + wave * 16384);
        int it = gw;
#define JOB(W_, ldw_, scol_, ncols_, K_, gain_, dst_, ldk_, koff_, kind_, rbase_) tr_job(it, NGW, W_, ldw_, scol_, ncols_, K_, gain_, (bf16_t*)(ws + (dst_)), ldk_, koff_, kind_, rbase_, scr, lane);
#define JOBF(W_, ldw_, scol_, ncols_, K_, gain_, dst_, ldk_, koff_, kind_, rbase_) tr_job(it, NGW, W_, ldw_, scol_, ncols_, K_, gain_, (bf16_t*)(ws + (dst_)), ldk_, koff_, kind_, rbase_, scr, lane, true);
        JOB(ap->a_w_in, 3584, 0, 3584, 2048, ap->g_mix_pre, WS_WAIN, 2048, 0, 0, 0)
        JOB(ap->w_o, 2048, 0, 2048, 2048, nullptr, WS_WO0, 2048, 0, 0, 0)
        JOB(ap->w_ff1, 8192, 0, 8192, 2048, ap->g_mlp_pre, WS_WFF1_0, 2048, 0, 0, 0)
        JOB(ap->w_ff2, 2048, 0, 2048, 8192, nullptr, WS_WFF2_0, LDF, 0, 0, 0)
        JOB(ap->w_mem_k, 512, 0, 512, 2048, ap->g_mem, WS_WMEM0, 2048, 0, 0, 0)
        JOB(ap->w_mem_v, 512, 0, 512, 2048, ap->g_mem, WS_WMEM0, 2048, 0, 0, 512)
        JOB(ap->w_mem_k + 2048 * 512, 512, 0, 512, 2048, ap->g_mem + 2048, WS_WMEM1, 2048, 0, 0, 0)
        JOB(ap->w_mem_v + 2048 * 512, 512, 0, 512, 2048, ap->g_mem + 2048, WS_WMEM1, 2048, 0, 0, 512)
        JOBF(ap->w_o + 2048 * 2048, 2048, 0, 2048, 2048, nullptr, WS_WO1, 2048, 0, 0, 0)
        JOBF(ap->w_ff1 + 2048 * 8192, 8192, 0, 8192, 2048, ap->g_mlp_pre + 2048, WS_WFF1_1, 2048, 0, 0, 0)
        JOBF(ap->b_w_in, 1280, 0, 1280, 2048, ap->g_mix_pre + 2048, WS_WBIN, 2048, 0, 0, 0)
        JOBF(ap->kv_w_down, 576, 0, 512, 2048, ap->kv_g_in, WS_WBIN, 2048, 0, 0, 1280)
        JOBF(ap->kv_w_down, 576, 512, 64, 2048, ap->kv_g_in, WS_WBIN, 2048, 0, 2, 1792)
        JOBF(ap->b_w_qb, 2304, 0, 2304, 768, ap->b_g_qa, WS_WQB, 768, 0, 1, 0)
        JOBF(ap->kv_w_up, 3072, 0, 3072, 512, ap->kv_g_latent, WS_WUP, 512, 0, 0, 0)
        for (int blk = 0; blk < 12; ++blk) {
            JOB(ap->a_w_r + blk * 16384, 128, 0, 128, 128, nullptr, WS_WGATE + (size_t)(blk >> 1) * 512 * 256 * 2, 256, (blk & 1) * 128, 0, (blk & 1) * 256)
            JOB(ap->a_w_i + blk * 16384, 128, 0, 128, 128, nullptr, WS_WGATE + (size_t)(blk >> 1) * 512 * 256 * 2, 256, (blk & 1) * 128, 0, (blk & 1) * 256 + 128)
        }
#undef JOB
#undef JOBF
        __syncthreads();
    }
    cg::this_grid().sync();

    if ((PHMASK >> 1) & 1) { PHASE_BEGIN
        { EpiA1 e{WSP(bf16_t, WS_XBR), WSP(bf16_t, WS_GG), WSP(bf16_t, WS_QMA), WSP(const float, WS_RSTD)};
          RUN_GEMM(EpiA1, e, WSP(const bf16_t, WS_HB), WSP(const bf16_t, WS_WAIN), 2048, 2048, 2048, T, 3584, bx); }
        { EpiStd<0> e{WSP(bf16_t, WS_MEMKV), 1024, WSP(const float, WS_RSTDMEM), 0.f, 1.f};
          RUN_GEMM(EpiStd<0>, e, WSP(const bf16_t, WS_MEMB), WSP(const bf16_t, WS_WMEM0), 2048, 2048, 2048, 1024, 1024, (bx + G - 128 % G) % G); }
        { EpiStd<0> e{WSP(bf16_t, WS_MEMKV + 2 * MiB), 1024, WSP(const float, WS_RSTDMEM), 0.f, 1.f};
          RUN_GEMM(EpiStd<0>, e, WSP(const bf16_t, WS_MEMB), WSP(const bf16_t, WS_WMEM1), 2048, 2048, 2048, 1024, 1024, (bx + G - 144 % G) % G); }
        { const int nidle = G > 160 ? G - 160 : G, first = G > 160 ? 160 : 0;
          if (bx >= first) { LAS float* scr = (LAS float*)(ldsl + wave * 16384); int it = (bx - first) * 8 + wave;
              tr_job(it, nidle * 8, ap->w_ff2 + 2048 * 8192, 2048, 0, 2048, 8192, nullptr, WSP(bf16_t, WS_WFF2_1), LDF, 0, 0, 0, scr, lane, true); } }
    }
    SEAM();

    if ((PHMASK >> 2) & 1) { PHASE_BEGIN
        const bf16_t* xbr = WSP(const bf16_t, WS_XBR); bf16_t* xc = WSP(bf16_t, WS_XC); const float* cw = ap->a_conv_w; const float* cb = ap->a_conv_b;
        for (int task = gt; task < 512 * 192; task += NGT) { const int r = task / 192, c8 = (task - r * 192) * 8, t0 = r * 32;
            f32x4 wl[4], wh[4];
#pragma unroll
            for (int j = 0; j < 4; ++j) { wl[j] = *(const f32x4*)(cw + j * 1536 + c8); wh[j] = *(const f32x4*)(cw + j * 1536 + c8 + 4); }
            const f32x4 bl = *(const f32x4*)(cb + c8), bh = *(const f32x4*)(cb + c8 + 4);
            const bf16_t* xp = xbr + (size_t)t0 * 1536 + c8; bf16_t* op = xc + (size_t)t0 * 1536 + c8;
            u32x4 x0 = {0u, 0u, 0u, 0u}, x1 = x0, x2 = x0;
            if ((t0 & (SEQ - 1)) != 0) { x0 = *(const u32x4*)(xp - 3 * 1536); x1 = *(const u32x4*)(xp - 2 * 1536); x2 = *(const u32x4*)(xp - 1536); }
#define CMAC(al, ah, wlo, whi, xv) do { al[0] += wlo[0] * bflo(xv.x); al[1] += wlo[1] * bfhi(xv.x); al[2] += wlo[2] * bflo(xv.y); al[3] += wlo[3] * bfhi(xv.y); \
                ah[0] += whi[0] * bflo(xv.z); ah[1] += whi[1] * bfhi(xv.z); ah[2] += whi[2] * bflo(xv.w); ah[3] += whi[3] * bfhi(xv.w); } while (0)
#pragma unroll 8
            for (int s = 0; s < 32; ++s) { const u32x4 x3 = *(const u32x4*)(xp + (size_t)s * 1536);
                f32x4 a0 = bl, a1 = bh;
                CMAC(a0, a1, wl[0], wh[0], x0); CMAC(a0, a1, wl[1], wh[1], x1); CMAC(a0, a1, wl[2], wh[2], x2); CMAC(a0, a1, wl[3], wh[3], x3);
                u32x4 o; o.x = cvt_pk_bf16(a0[0], a0[1]); o.y = cvt_pk_bf16(a0[2], a0[3]); o.z = cvt_pk_bf16(a1[0], a1[1]); o.w = cvt_pk_bf16(a1[2], a1[3]);
                *(u32x4*)(op + (size_t)s * 1536) = o; x0 = x1; x1 = x2; x2 = x3; }
#undef CMAC
        }
        __syncthreads();
        for (int u = bx; u < 256; u += G) { const int qb = u & 15, h = (u >> 4) & 3, b = u >> 6;
            const bf16_t* mkv = WSP(const bf16_t, WS_MEMKV) + (size_t)(b * 256) * 1024 + h * 128;
            AttnArgs a{WSP(const bf16_t, WS_QMA) + (size_t)(b * SEQ + qb * 256) * 512 + h * 128, 512, mkv, 1024, nullptr, mkv + 512, 1024,
                       WSP(bf16_t, WS_CC) + (size_t)(b * SEQ + qb * 256) * DM + 1536 + h * 128, DM, 4, 1 << 20};
            attn_unit<8>(a, (char*)lds); }
    }
    SEAM();

    if ((PHMASK >> 3) & 1) { PHASE_BEGIN
        EpiGate e{WSP(const bf16_t, WS_XC), ap->a_b_r, ap->a_b_i, WSP(unsigned, WS_RU)};
        pg8::Gemm g_{WSP(const bf16_t, WS_XC), WSP(const bf16_t, WS_WGATE), 1536, 256, 256, 512, (size_t)512 * 256 * 2};
        SO S_; S_.init(T, 3072, G, bx, 2);
        pg8::gemm_phase<EpiGate, SO, true, true>(ldsl, g_, S_, e);
    }
    SEAM();

    if ((PHMASK >> 4) & 1) { PHASE_BEGIN
        const unsigned* RU = WSP(const unsigned, WS_RU); float2* agg = WSP(float2, WS_AGG); const float* lam = ap->a_lambda;
        for (int u = bx; u < 768; u += G) { const int slab = u % 3, k = (u / 3) & 63, b = u / 192, ch = slab * 512 + tid;
            const float c2 = -8.f * 1.4426950408889634f * log1pf(__expf(-lam[ch]));
            const unsigned* p = RU + (size_t)(b * SEQ + k * 64) * 1536 + ch; float Aa = 1.f, Bb = 0.f;
#pragma unroll 16
            for (int i = 0; i < 64; ++i) { const unsigned w = p[(size_t)i * 1536]; const float a = __builtin_amdgcn_exp2f(bflo(w) * c2);
                const float bb = sqrtf(fmaxf(1.f - a * a, 0.f)) * bfhi(w); Bb = a * Bb + bb; Aa *= a; }
            agg[(size_t)(b * 64 + k) * 1536 + ch] = make_float2(Aa, Bb); }
    }
    SEAM();

    if ((PHMASK >> 5) & 1) { PHASE_BEGIN
        const unsigned* RU = WSP(const unsigned, WS_RU); const float2* agg = WSP(const float2, WS_AGG); const bf16_t* gg = WSP(const bf16_t, WS_GG); const float* lam = ap->a_lambda;
        for (int u = bx; u < 768; u += G) { const int slab = u % 3, k = (u / 3) & 63, b = u / 192, ch = slab * 512 + tid;
            const float c2 = -8.f * 1.4426950408889634f * log1pf(__expf(-lam[ch]));
            float h = 0.f;
            for (int kk = 0; kk < k; kk += 8) { float2 ab[8];
#pragma unroll
                for (int j = 0; j < 8; ++j) ab[j] = (kk + j < k) ? agg[(size_t)(b * 64 + kk + j) * 1536 + ch] : make_float2(1.f, 0.f);
#pragma unroll
                for (int j = 0; j < 8; ++j) h = ab[j].x * h + ab[j].y; }
            const size_t r0 = (size_t)(b * SEQ + k * 64);
            const unsigned* p = RU + r0 * 1536 + ch; const bf16_t* gp = gg + r0 * 1536 + ch; bf16_t* op = WSP(bf16_t, WS_CC) + r0 * DM + ch;
#pragma unroll 16
            for (int i = 0; i < 64; ++i) { const unsigned w = p[(size_t)i * 1536]; const float a = __builtin_amdgcn_exp2f(bflo(w) * c2);
                const float bb = sqrtf(fmaxf(1.f - a * a, 0.f)) * bfhi(w); h = a * h + bb;
                const float gv = __uint_as_float((unsigned)gp[(size_t)i * 1536] << 16);
                op[(size_t)i * DM] = (bf16_t)(cvt_pk_bf16(h * gv, 0.f) & 0xffffu); } }
    }
    SEAM();

#pragma unroll
    for (int layer = 0; layer < 2; ++layer) {
        if (layer == 1) {
            if ((PHMASK >> 6) & 1) { PHASE_BEGIN
                EpiB1 e{WSP(bf16_t, WS_CQ), WSP(bf16_t, WS_QMB), WSP(bf16_t, WS_CKV), WSP(bf16_t, WS_KPE), WSP(float, WS_SSQCQ), WSP(float, WS_SSQLAT), WSP(const float, WS_SSQH) + T, WSP(const float, WS_COS), WSP(const float, WS_SIN)};
                RUN_GEMM(EpiB1, e, WSP(const bf16_t, WS_HB), WSP(const bf16_t, WS_WBIN), 2048, 2048, 2048, T, 2048, bx);
            }
            SEAM();
            if ((PHMASK >> 7) & 1) { PHASE_BEGIN
                { EpiStd<0> e{WSP(bf16_t, WS_KV), 3072, WSP(const float, WS_SSQLAT), 1.f / 512.f, 1.f};
                  RUN_GEMM(EpiStd<0>, e, WSP(const bf16_t, WS_CKV), WSP(const bf16_t, WS_WUP), 512, 512, 512, T, 3072, bx); }
                { EpiQ e{WSP(bf16_t, WS_Q), WSP(const float, WS_SSQCQ), WSP(const float, WS_COS), WSP(const float, WS_SIN)};
                  RUN_GEMM(EpiQ, e, WSP(const bf16_t, WS_CQ), WSP(const bf16_t, WS_WQB), 768, 768, 768, T, 2304, bx); }
            }
            SEAM();
            if ((PHMASK >> 8) & 1) { PHASE_BEGIN
                for (int slot = 0; slot < (G == 256 ? ATT_SLOTS : 1024 / G + 1); ++slot) {
                    int code;
                    if (G == 256) code = g_att_sched[bx][slot]; else { const int p = slot * G + bx; code = p < 1024 ? (p < 768 ? p : 1024 + (p - 768)) : 0xFFFF; }
                    if (code == 0xFFFF) continue;
                    if (code < 1024) { const int qb = code & 15, bh = code >> 4, b = bh / 12, h = bh - b * 12;
                        const bf16_t* kv = WSP(const bf16_t, WS_KV) + (size_t)(b * SEQ) * 3072 + h * 256;
                        AttnArgs a{WSP(const bf16_t, WS_Q) + (size_t)(b * SEQ + qb * 256) * 2304 + h * 192, 2304, kv, 3072, WSP(const bf16_t, WS_KPE) + (size_t)(b * SEQ) * 64,
                                   kv + 128, 3072, WSP(bf16_t, WS_CC) + (size_t)(b * SEQ + qb * 256) * DM + h * 128, DM, 4 * qb + 4, 4 * qb};
                        attn_unit<12>(a, (char*)lds); }
                    else { const int u = code - 1024, qb = u & 15, h = (u >> 4) & 3, b = u >> 6;
                        const bf16_t* mkv = WSP(const bf16_t, WS_MEMKV + 2 * MiB) + (size_t)(b * 256) * 1024 + h * 128;
                        AttnArgs a{WSP(const bf16_t, WS_QMB) + (size_t)(b * SEQ + qb * 256) * 512 + h * 128, 512, mkv, 1024, nullptr, mkv + 512, 1024,
                                   WSP(bf16_t, WS_CC) + (size_t)(b * SEQ + qb * 256) * DM + 1536 + h * 128, DM, 4, 1 << 20};
                        attn_unit<8>(a, (char*)lds); }
                }
            }
            SEAM();
        }
        const size_t wo_off = layer ? WS_WO1 : WS_WO0, wf1_off = layer ? WS_WFF1_1 : WS_WFF1_0, wf2_off = layer ? WS_WFF2_1 : WS_WFF2_0;
#pragma unroll
        for (int hf = 0; hf < 2; ++hf) {
            if ((PHMASK >> 10) & 1) { PHASE_BEGIN
                LAS float* Pl = (LAS float*)(ldsl + 131072 + 1024);
                if (layer == 0) { EpiNorm<true, false> e{ap->x, WSP(bf16_t, WS_HB), nullptr, ap->g_mix_post, WSP(float, WS_SSQY), WSP(float, WS_SSQH), WSP(unsigned, WS_CNT), hf * 8192, Pl};
                    RUN_GEMM(EN_TF, e, WSP(const bf16_t, WS_CC) + (size_t)hf * 8192 * DM, (const bf16_t*)(ws + wo_off), 2048, 2048, 2048, 8192, 2048, bx); }
                else { EpiNorm<false, false> e{nullptr, WSP(bf16_t, WS_HB), nullptr, ap->g_mix_post + DM, WSP(float, WS_SSQY) + 2 * T, WSP(float, WS_SSQH) + 2 * T, WSP(unsigned, WS_CNT) + 2 * 64 * 64, hf * 8192, Pl};
                    RUN_GEMM(EN_FF, e, WSP(const bf16_t, WS_CC) + (size_t)hf * 8192 * DM, (const bf16_t*)(ws + wo_off), 2048, 2048, 2048, 8192, 2048, bx); }
            }
            if (hf == 1) SEAM();
        }
#pragma unroll
        for (int hf = 0; hf < 2; ++hf) {
            if ((PHMASK >> 12) & 1) { PHASE_BEGIN EpiStd<2> e{WSP(bf16_t, WS_F), LDF, WSP(const float, WS_SSQH) + (layer * 2) * T + hf * 8192, 1.f / DM, 1.f};
                RUN_GEMM(EpiStd<2>, e, WSP(const bf16_t, WS_HB) + (size_t)hf * 8192 * DM, (const bf16_t*)(ws + wf1_off), 2048, 2048, 2048, 8192, 8192, bx); }
            SEAM();
            if ((PHMASK >> 13) & 1) { PHASE_BEGIN
                LAS float* Pl = (LAS float*)(ldsl + 131072 + 1024);
                if (layer == 0) { EpiNorm<false, false> e{nullptr, WSP(bf16_t, WS_HB), nullptr, ap->g_mlp_post, WSP(float, WS_SSQY) + T, WSP(float, WS_SSQH) + T, WSP(unsigned, WS_CNT) + 64 * 64, hf * 8192, Pl};
                    RUN_GEMM(EN_FF, e, WSP(const bf16_t, WS_F), (const bf16_t*)(ws + wf2_off), LDF, LDF, 8192, 8192, 2048, bx); }
                else { EpiNorm<false, true> e{nullptr, WSP(bf16_t, WS_HB), ap->out, ap->g_mlp_post + DM, WSP(float, WS_SSQY) + 3 * T, WSP(float, WS_SSQH) + 3 * T, WSP(unsigned, WS_CNT) + 3 * 64 * 64, hf * 8192, Pl};
                    RUN_GEMM(EN_FT, e, WSP(const bf16_t, WS_F), (const bf16_t*)(ws + wf2_off), LDF, LDF, 8192, 8192, 2048, bx); }
            }
            if (!(layer == 1 && hf == 1)) SEAM();
        }
    }
#undef SEAM
}

extern "C" void kernel_launch(void* const* d_in, const int* in_sizes, int n_in, void* d_out, int out_size, void* d_ws, size_t ws_size, hipStream_t stream) {
    static int grid = 0;
    if (grid == 0) {
        if (n_in != 28 || in_sizes[0] != T * DM || out_size != T * DM || ws_size < WS_END) {
            fprintf(stderr, "kernel_launch: unexpected shapes: n_in %d in0 %d out %d ws %zu (need %zu)\n", n_in, n_in > 0 ? in_sizes[0] : -1, out_size, ws_size, (size_t)WS_END); grid = -1; return; }
        int dev = 0, cus = 0, per_cu = 0;
        (void)hipGetDevice(&dev); (void)hipDeviceGetAttribute(&cus, hipDeviceAttributeMultiprocessorCount, dev);
        if (hipFuncSetAttribute((const void*)fwd_mega, hipFuncAttributeMaxDynamicSharedMemorySize, LDS_BYTES) != hipSuccess) fprintf(stderr, "kernel_launch: hipFuncSetAttribute failed\n");
        if (hipOccupancyMaxActiveBlocksPerMultiprocessor(&per_cu, (const void*)fwd_mega, 512, LDS_BYTES) != hipSuccess || per_cu < 1) { fprintf(stderr, "kernel_launch: occupancy query says %d\n", per_cu); per_cu = 1; }
        (void)hipGetLastError();
        grid = cus * 1;
        if (grid <= 0) grid = 256;
    }
    if (grid < 0) return;
    Args a{};
    a.x = (const float*)d_in[0]; a.mem = (const float*)d_in[1]; a.pos = (const int*)d_in[2];
    a.g_mix_pre = (const float*)d_in[3]; a.g_mix_post = (const float*)d_in[4]; a.g_mlp_pre = (const float*)d_in[5]; a.g_mlp_post = (const float*)d_in[6]; a.g_mem = (const float*)d_in[7];
    a.w_mem_k = (const float*)d_in[8]; a.w_mem_v = (const float*)d_in[9]; a.w_o = (const float*)d_in[10]; a.w_ff1 = (const float*)d_in[11]; a.w_ff2 = (const float*)d_in[12];
    a.a_w_in = (const float*)d_in[13]; a.a_conv_w = (const float*)d_in[14]; a.a_conv_b = (const float*)d_in[15]; a.a_w_r = (const float*)d_in[16]; a.a_b_r = (const float*)d_in[17];
    a.a_w_i = (const float*)d_in[18]; a.a_b_i = (const float*)d_in[19]; a.a_lambda = (const float*)d_in[20];
    a.b_w_in = (const float*)d_in[21]; a.b_g_qa = (const float*)d_in[22]; a.b_w_qb = (const float*)d_in[23];
    a.kv_g_in = (const float*)d_in[24]; a.kv_w_down = (const float*)d_in[25]; a.kv_g_latent = (const float*)d_in[26]; a.kv_w_up = (const float*)d_in[27 + 0];
    a.out = (float*)d_out; a.ws = (unsigned char*)d_ws;
    for (int i = 0; i < 32; ++i) a.invf[i] = (float)pow(10000.0, -(double)i / 32.0);
    a.ph_lo = 0; a.ph_hi = 1000;
    (void)hipMemsetAsync((unsigned char*)d_ws + WS_BAR, 0, 16384, stream);
    void* kargs[] = {&a};
    hipError_t e = hipLaunchCooperativeKernel((const void*)fwd_mega, dim3(grid), dim3(512), kargs, LDS_BYTES, stream);
    if (e != hipSuccess) fprintf(stderr, "kernel_launch: cooperative launch failed: %s (grid %d)\n", hipGetErrorString(e), grid);
}
```

```cpp
#include <hip/hip_runtime.h>
#include <hip/hip_cooperative_groups.h>
#include <cstdio>
#include <cstdint>
#include <cmath>
namespace cg = cooperative_groups;

#define LAS __attribute__((address_space(3)))
typedef unsigned short bf16_t;
typedef short bf16x8 __attribute__((ext_vector_type(8)));
typedef short s16x4 __attribute__((ext_vector_type(4)));
typedef float f32x4 __attribute__((ext_vector_type(4)));
typedef float f32x16 __attribute__((ext_vector_type(16)));
typedef unsigned u32x4 __attribute__((ext_vector_type(4)));
typedef unsigned u32x2 __attribute__((ext_vector_type(2)));

constexpr int T = 16384, DM = 2048, SEQ = 4096, NBATCH = 4;
constexpr float EPS = 1e-6f;
constexpr float MEMSCALE = 0.08838834764831845f * 1.4426950408889634f;
constexpr float QSCALE = 0.07216878364870322f * 1.4426950408889634f;
constexpr size_t MiB = 1u << 20;
constexpr size_t WS_RSTD = 0, WS_SSQCQ = 65536, WS_SSQLAT = 131072, WS_RSTDMEM = 196608;
constexpr size_t WS_BAR = 262144;
constexpr size_t WS_SSQY = 320 * 1024, WS_SSQH = 576 * 1024, WS_CNT = 832 * 1024, WS_CTL_ZERO_END = 896 * 1024;
constexpr size_t WS_MEMKV = 1 * MiB;
constexpr size_t WS_COS = 5 * MiB, WS_SIN = 7 * MiB;
constexpr int LDF = 8192 + 64;
constexpr size_t KiB = 1024;
constexpr size_t WS_WAIN = 9 * MiB, WS_WO0 = 23 * MiB, WS_WFF1_0 = 31 * MiB, WS_WFF2_0 = 63 * MiB, WS_WGATE = 95 * MiB + 256 * KiB, WS_WMEM0 = 96 * MiB + 768 * KiB, WS_WMEM1 = 100 * MiB + 768 * KiB,
                 WS_WO1 = 104 * MiB + 768 * KiB, WS_WFF1_1 = 112 * MiB + 768 * KiB, WS_WFF2_1 = 144 * MiB + 768 * KiB, WS_WBIN = 177 * MiB, WS_WQB = 185 * MiB, WS_WUP = 188 * MiB + 384 * KiB;
static_assert(WS_WFF2_0 + (size_t)2048 * LDF * 2 <= WS_WGATE && WS_WFF2_1 + (size_t)2048 * LDF * 2 <= WS_WBIN && WS_WUP + 3 * MiB <= 192 * MiB, "weight map");
constexpr size_t WS_HB = 192 * MiB, WS_Y = 256 * MiB, WS_CC = 320 * MiB, WS_ARENA = 384 * MiB, WS_END = 512 * MiB;
constexpr size_t WS_GG = WS_Y;
constexpr size_t WS_MEMB = WS_Y + 48 * MiB;
constexpr size_t WS_XBR = WS_ARENA, WS_QMA = WS_ARENA + 48 * MiB;
constexpr size_t WS_XC = WS_HB;
constexpr size_t WS_RU = WS_ARENA;
constexpr size_t WS_AGG = WS_ARENA + 96 * MiB;
constexpr size_t WS_F = WS_ARENA - 1 * MiB;
constexpr size_t WS_CQ = WS_Y, WS_QMB = WS_Y + 24 * MiB, WS_CKV = WS_Y + 40 * MiB, WS_KPE = WS_Y + 56 * MiB;
constexpr size_t WS_Q = WS_WAIN;
constexpr size_t WS_KV = WS_ARENA;
static_assert(WS_F + (size_t)8192 * LDF * 2 <= WS_END && WS_Q + 72 * MiB <= WS_WMEM1 + 4 * MiB, "map");

namespace pg8 {
constexpr int BM = 256, BK = 64, HALF = 128, HTB = HALF * BK * 2, STAGE_BYTES = 8 * HTB, NXCD = 8, WGM = 8;
__host__ __device__ __forceinline__ int lds_byte(int r, int c) { const int st = (r >> 4) * 2 + (c >> 5), rr = r & 15, cc = c & 31, ob = rr * 64 + cc * 2; return st * 1024 + (ob ^ (((ob >> 9) & 1) << 5)); }
__host__ __device__ __forceinline__ void stage_rc(int b, int& R, int& C) { const int st = b / 1024, sb = b % 1024, swz = sb ^ (((sb >> 9) & 1) << 5); R = (st >> 1) * 16 + swz / 64; C = (st & 1) * 32 + (swz % 64) / 2; }
__host__ __device__ __forceinline__ int perm32(int rho) { const int n = rho >> 4, i = rho & 15; return 8 * (i >> 2) + 4 * n + (i & 3); }

struct Unit { int pm, pn, g; };
struct Gemm { const bf16_t* A; const bf16_t* Bt; int lda, ldb, K; size_t gsA, gsB; };

struct StaticOrder {
    int nM, nN, nwg, G, c, gdiv;
    __device__ void init(int M, int N, int G_, int c_, int gdiv_ = 1 << 20) { nM = M / BM; nN = N / BM; nwg = nM * nN; G = G_; c = c_; gdiv = gdiv_; }
    __device__ bool next(int i, Unit& u) const {
        const long L = (long)i * G + c; if (L >= nwg) return false;
        int wgid = (int)L; { const int q = nwg / NXCD, r = nwg % NXCD, xcd = wgid % NXCD, off = wgid / NXCD; wgid = (xcd < r ? xcd * (q + 1) : r * (q + 1) + (xcd - r) * q) + off; }
        const int nig = WGM * nN, gid = wgid / nig, fm = gid * WGM, gsz = (nM - fm) < WGM ? (nM - fm) : WGM;
        u.pm = fm + ((wgid % nig) % gsz); const int pnv = (wgid % nig) / gsz; u.g = pnv / gdiv; u.pn = pnv - u.g * gdiv; return true;
    }
    __device__ __forceinline__ void a_ready(const Unit&) const {}
    __device__ __forceinline__ void done(const Unit&) const {}
};

__device__ __forceinline__ unsigned cvt_pk_bf16(float lo, float hi) { unsigned r; asm volatile("v_cvt_pk_bf16_f32 %0, %1, %2" : "=v"(r) : "v"(lo), "v"(hi)); return r; }

template <class Epi, class Sched, bool ALIGN_EPI = false, bool SP2 = false>
__device__ __forceinline__ void gemm_phase(LAS unsigned char* lds, const Gemm g, const Sched& S, const Epi& E) {
    int tid_ = threadIdx.x; asm volatile("" : "+v"(tid_));
    const int tid = tid_, wid = __builtin_amdgcn_readfirstlane(tid >> 6), lane = tid & 63, wr = wid >> 2, wc = wid & 3, fr = lane & 15, fq = lane >> 4;
    const int K = g.K, nt = K / BK;
    unsigned voffA[2], voffB[2];
#pragma unroll
    for (int i = 0; i < 2; ++i) { int R, C; stage_rc(tid * 16 + i * 8192, R, C); const int Rb = Epi::PERM ? ((R & ~31) + perm32(R & 31)) : R;
        voffA[i] = (unsigned)(R * g.lda + C) * 2u; voffB[i] = (unsigned)(Rb * g.ldb + C) * 2u; }
    const size_t kstep = (size_t)(BK * 2);
    const size_t hstepA = (size_t)HALF * g.lda * 2, hstepB = (size_t)HALF * g.ldb * 2;
    const size_t tstepA = 2 * hstepA, tstepB = 2 * hstepB;
    const unsigned ldsw = (unsigned)wid * 1024u;
    const int aoff = lds_byte(wr * 64 + fr, fq * 8), boff = lds_byte(wc * 32 + fr, fq * 8);
#define PG8_SA(b, h) (((b) * 2 + (h)) * HTB)
#define PG8_SB(b, h) ((4 + (b) * 2 + (h)) * HTB)
#define PG8_STAGE(bufoff, gbase, voff) do { _Pragma("unroll") for (int _i = 0; _i < 2; ++_i) \
        __builtin_amdgcn_global_load_lds((const unsigned*)((const char*)(gbase) + (voff)[_i]), (LAS unsigned*)(lds + (bufoff) + ldsw + _i * 8192), 16, 0, 0); } while (0)
#define PG8_LDA(dst, b, h) do { _Pragma("unroll") for (int m = 0; m < 4; ++m) _Pragma("unroll") for (int k = 0; k < 2; ++k) dst[m][k] = *(const LAS bf16x8*)(lds + PG8_SA(b, h) + aoff + m * 2048 + k * 1024); } while (0)
#define PG8_LDB(dst, b, h) do { _Pragma("unroll") for (int n = 0; n < 2; ++n) _Pragma("unroll") for (int k = 0; k < 2; ++k) dst[n][k] = *(const LAS bf16x8*)(lds + PG8_SB(b, h) + boff + n * 2048 + k * 1024); } while (0)
#define PG8_MMA(ai, bj, At, Bt) do { __builtin_amdgcn_s_setprio(1); _Pragma("unroll") for (int m = 0; m < 4; ++m) _Pragma("unroll") for (int n = 0; n < 2; ++n) _Pragma("unroll") for (int k = 0; k < 2; ++k) \
        acc[ai][bj][m][n] = __builtin_amdgcn_mfma_f32_16x16x32_bf16(Bt[n][k], At[m][k], acc[ai][bj][m][n], 0, 0, 0); __builtin_amdgcn_s_setprio(0); } while (0)
#define PG8_WAIT_V(n) asm volatile("s_waitcnt vmcnt(" #n ")" ::: "memory")
#define PG8_WAIT_L(n) asm volatile("s_waitcnt lgkmcnt(" #n ")" ::: "memory")
#define PG8_BAR __builtin_amdgcn_s_barrier()
#define PG8_SCHED __builtin_amdgcn_sched_barrier(0)
    Unit cur, nxt; int ui = 0;
    if (!S.next(0, cur)) return;
    f32x4 acc[2][2][4][2];
#pragma unroll
    for (int a = 0; a < 2; ++a)
#pragma unroll
        for (int b = 0; b < 2; ++b)
#pragma unroll
            for (int m = 0; m < 4; ++m)
#pragma unroll
                for (int n = 0; n < 2; ++n) acc[a][b][m][n] = (f32x4){0.f, 0.f, 0.f, 0.f};
    bf16x8 At[4][2], B0[2][2], B1[2][2];
    const char* cA = (const char*)g.A + (size_t)cur.g * g.gsA + (size_t)cur.pm * tstepA; const char* cB = (const char*)g.Bt + (size_t)cur.g * g.gsB + (size_t)cur.pn * tstepB;
    S.a_ready(cur);
    if constexpr (SP2) {
        PG8_STAGE(PG8_SB(0, 0), cB, voffB); PG8_STAGE(PG8_SB(0, 1), cB + hstepB, voffB); PG8_STAGE(PG8_SA(0, 0), cA, voffA); PG8_STAGE(PG8_SA(0, 1), cA + hstepA, voffA);
        if (wr == 1) PG8_BAR;
        PG8_WAIT_V(2); PG8_BAR;
        PG8_STAGE(PG8_SB(1, 0), cB + kstep, voffB); PG8_STAGE(PG8_SA(1, 0), cA + kstep, voffA); PG8_STAGE(PG8_SB(1, 1), cB + hstepB + kstep, voffB);
        PG8_WAIT_V(6); PG8_BAR;
    } else {
        PG8_STAGE(PG8_SB(0, 0), cB, voffB); PG8_STAGE(PG8_SA(0, 0), cA, voffA); PG8_STAGE(PG8_SB(0, 1), cB + hstepB, voffB); PG8_STAGE(PG8_SA(0, 1), cA + hstepA, voffA);
        if (wr == 1) PG8_BAR;
        PG8_WAIT_V(4); PG8_BAR;
        PG8_STAGE(PG8_SB(1, 0), cB + kstep, voffB); PG8_STAGE(PG8_SA(1, 0), cA + kstep, voffA); PG8_STAGE(PG8_SB(1, 1), cB + hstepB + kstep, voffB);
        PG8_WAIT_V(6); PG8_BAR;
    }
    for (;;) {
        const bool has_next = S.next(ui + 1, nxt);
        const char* nA = has_next ? (const char*)g.A + (size_t)nxt.g * g.gsA + (size_t)nxt.pm * tstepA : cA; const char* nB = has_next ? (const char*)g.Bt + (size_t)nxt.g * g.gsB + (size_t)nxt.pn * tstepB : cB;
        for (int t = 0; t < nt; t += 2) {
            const bool last = (t == nt - 2);
            const char* a1 = cA + (size_t)(t + 1) * kstep;
            const char* a2 = last ? nA : cA + (size_t)(t + 2) * kstep; const char* b2 = last ? nB : cB + (size_t)(t + 2) * kstep;
            const char* a3 = a2 + kstep; const char* b3 = b2 + kstep;
            if (last && has_next) S.a_ready(nxt);
            if constexpr (SP2) {
            PG8_LDB(B0, 0, 0); PG8_LDB(B1, 0, 1); PG8_SCHED; PG8_LDA(At, 0, 0); PG8_STAGE(PG8_SA(1, 1), a1 + hstepA, voffA);
            PG8_WAIT_V(8); PG8_WAIT_L(0); PG8_BAR; PG8_MMA(0, 0, At, B0); PG8_MMA(0, 1, At, B1); PG8_BAR; PG8_SCHED;
            PG8_LDA(At, 0, 1); PG8_STAGE(PG8_SB(0, 0), b2, voffB); PG8_STAGE(PG8_SB(0, 1), b2 + hstepB, voffB); PG8_STAGE(PG8_SA(0, 0), a2, voffA);
            PG8_WAIT_V(8); PG8_WAIT_L(0); PG8_BAR; PG8_MMA(1, 0, At, B0); PG8_MMA(1, 1, At, B1); PG8_BAR; PG8_SCHED;
            PG8_LDB(B0, 1, 0); PG8_LDB(B1, 1, 1); PG8_SCHED; PG8_LDA(At, 1, 0); PG8_STAGE(PG8_SA(0, 1), a2 + hstepA, voffA);
            PG8_WAIT_V(8); PG8_WAIT_L(0); PG8_BAR; PG8_MMA(0, 0, At, B0); PG8_MMA(0, 1, At, B1); PG8_BAR; PG8_SCHED;
            PG8_LDA(At, 1, 1); PG8_STAGE(PG8_SB(1, 0), b3, voffB); PG8_STAGE(PG8_SB(1, 1), b3 + hstepB, voffB); PG8_STAGE(PG8_SA(1, 0), a3, voffA);
            PG8_WAIT_V(8); PG8_WAIT_L(0); PG8_BAR; PG8_MMA(1, 0, At, B0); PG8_MMA(1, 1, At, B1); PG8_BAR; PG8_SCHED;
            } else {
            PG8_LDB(B0, 0, 0); PG8_SCHED; PG8_LDA(At, 0, 0); PG8_STAGE(PG8_SA(1, 1), a1 + hstepA, voffA);
            PG8_WAIT_L(8); PG8_BAR; PG8_WAIT_L(0); PG8_MMA(0, 0, At, B0); PG8_BAR; PG8_SCHED;
            PG8_LDB(B1, 0, 1); PG8_STAGE(PG8_SB(0, 0), b2, voffB);
            PG8_BAR; PG8_WAIT_L(0); PG8_MMA(0, 1, At, B1); PG8_BAR;
            PG8_LDA(At, 0, 1); PG8_STAGE(PG8_SA(0, 0), a2, voffA);
            PG8_BAR; PG8_WAIT_L(0); PG8_MMA(1, 0, At, B0); PG8_BAR; PG8_SCHED;
            PG8_STAGE(PG8_SB(0, 1), b2 + hstepB, voffB);
            PG8_WAIT_V(6); PG8_BAR; PG8_MMA(1, 1, At, B1); PG8_BAR;
            PG8_LDB(B0, 1, 0); PG8_SCHED; PG8_LDA(At, 1, 0); PG8_STAGE(PG8_SA(0, 1), a2 + hstepA, voffA);
            PG8_WAIT_L(8); PG8_BAR; PG8_WAIT_L(0); PG8_MMA(0, 0, At, B0); PG8_BAR; PG8_SCHED;
            PG8_LDB(B1, 1, 1); PG8_STAGE(PG8_SB(1, 0), b3, voffB);
            PG8_BAR; PG8_WAIT_L(0); PG8_MMA(0, 1, At, B1); PG8_BAR;
            PG8_LDA(At, 1, 1); PG8_STAGE(PG8_SA(1, 0), a3, voffA);
            PG8_BAR; PG8_WAIT_L(0); PG8_MMA(1, 0, At, B0); PG8_BAR; PG8_SCHED;
            PG8_STAGE(PG8_SB(1, 1), b3 + hstepB, voffB);
            PG8_WAIT_V(6); PG8_BAR; PG8_MMA(1, 1, At, B1); PG8_BAR;
            }
        }
        if constexpr (ALIGN_EPI) { if (wr == 0) PG8_BAR; }
        { int fr2 = fr, fq2 = fq; asm volatile("" : "+v"(fr2), "+v"(fq2)); E(acc, cur, wr, wc, fr2, fq2); } S.done(cur);
        if (!has_next) break;
#pragma unroll
        for (int a = 0; a < 2; ++a)
#pragma unroll
            for (int b = 0; b < 2; ++b)
#pragma unroll
                for (int m = 0; m < 4; ++m)
#pragma unroll
                    for (int n = 0; n < 2; ++n) acc[a][b][m][n] = (f32x4){0.f, 0.f, 0.f, 0.f};
        cur = nxt; cA = nA; cB = nB; ++ui;
        if constexpr (ALIGN_EPI) { if (wr == 1) PG8_BAR; }
    }
    PG8_WAIT_V(0);
    if constexpr (!ALIGN_EPI) { if (wr == 0) PG8_BAR; }
    PG8_BAR;
#undef PG8_SA
#undef PG8_SB
#undef PG8_STAGE
#undef PG8_LDA
#undef PG8_LDB
#undef PG8_MMA
#undef PG8_WAIT_V
#undef PG8_WAIT_L
#undef PG8_BAR
#undef PG8_SCHED
}
}
using pg8::cvt_pk_bf16;
using pg8::HALF;

__device__ __forceinline__ float bflo(unsigned w) { return __uint_as_float(w << 16); }
__device__ __forceinline__ float bfhi(unsigned w) { return __uint_as_float(w & 0xffff0000u); }
__device__ __forceinline__ float wave_sum(float v) {
#pragma unroll
    for (int o = 1; o < 64; o <<= 1) v += __shfl_xor(v, o);
    return v;
}
__device__ __forceinline__ float fast_sigmoid(float x) { return __builtin_amdgcn_rcpf(1.f + __builtin_amdgcn_exp2f(-1.4426950408889634f * x)); }
__device__ __forceinline__ float gelu_tanh(float v) { const float u = v + 0.044715f * v * v * v; return v * __builtin_amdgcn_rcpf(1.f + __builtin_amdgcn_exp2f(-2.302208198f * u)); }

template <int ACT>
__device__ __forceinline__ void store_perm(const f32x4 (&acc)[2][2][4][2], bf16_t* O, int ldc, int orow, int ocol, const float* rs, float inv_n, int grow, float cs) {
#pragma unroll
    for (int ai = 0; ai < 2; ++ai)
#pragma unroll
        for (int m = 0; m < 4; ++m) {
            const int ro = ai * HALF + m * 16;
            float s = cs;
            if (rs) { const float q = rs[grow + ro]; s *= (inv_n > 0.f) ? rsqrtf(q * inv_n + EPS) : q; }
            bf16_t* rowp = O + (size_t)(orow + ro) * ldc + ocol;
#pragma unroll
            for (int bj = 0; bj < 2; ++bj) {
                f32x4 v0 = acc[ai][bj][m][0] * s, v1 = acc[ai][bj][m][1] * s;
                if (ACT == 1) {
#pragma unroll
                    for (int j = 0; j < 4; ++j) { v0[j] = gelu_tanh(v0[j]); v1[j] = gelu_tanh(v1[j]); } }
                if (ACT == 2) {
#pragma unroll
                    for (int j = 0; j < 4; ++j) { const float a = fmaxf(v0[j], 0.f), b = fmaxf(v1[j], 0.f); v0[j] = a * a; v1[j] = b * b; } }
                u32x4 w; w.x = cvt_pk_bf16(v0[0], v0[1]); w.y = cvt_pk_bf16(v0[2], v0[3]); w.z = cvt_pk_bf16(v1[0], v1[1]); w.w = cvt_pk_bf16(v1[2], v1[3]);
                *(u32x4*)(rowp + bj * HALF) = w;
            }
        }
}
template <int ACT> struct EpiStd {
    static constexpr bool PERM = true;
    bf16_t* O; int ldc; const float* rs; float inv_n; float cs;
    __device__ __forceinline__ void operator()(const f32x4 (&acc)[2][2][4][2], const pg8::Unit& u, int wr, int wc, int fr, int fq) const {
        const int grow = u.pm * 256 + wr * 64 + fr;
        store_perm<ACT>(acc, O, ldc, grow, u.pn * 256 + wc * 32 + 8 * fq, rs, inv_n, grow, cs);
    }
};
struct EpiA1 {
    static constexpr bool PERM = true;
    bf16_t *xbr, *gg, *qm; const float* rs;
    __device__ __forceinline__ void operator()(const f32x4 (&acc)[2][2][4][2], const pg8::Unit& u, int wr, int wc, int fr, int fq) const {
        const int grow = u.pm * 256 + wr * 64 + fr, cl = wc * 32 + 8 * fq;
        if (u.pn < 6) store_perm<0>(acc, xbr, 1536, grow, u.pn * 256 + cl, rs, 0.f, grow, 1.f);
        else if (u.pn < 12) store_perm<1>(acc, gg, 1536, grow, (u.pn - 6) * 256 + cl, rs, 0.f, grow, 1.f);
        else store_perm<0>(acc, qm, 512, grow, (u.pn - 12) * 256 + cl, rs, 0.f, grow, MEMSCALE);
    }
};
struct EpiGate {
    static constexpr bool PERM = false;
    const bf16_t* xc; const float *br, *bi; unsigned* RU;
    __device__ __forceinline__ void operator()(const f32x4 (&acc)[2][2][4][2], const pg8::Unit& u, int wr, int wc, int fr, int fq) const {
        const int blk = 2 * u.g + u.pn, row0 = u.pm * 256 + wr * 64 + fr, chb = blk * 128 + wc * 32 + 4 * fq;
#pragma unroll
        for (int ai = 0; ai < 2; ++ai)
#pragma unroll
            for (int m = 0; m < 4; ++m) {
#pragma unroll
                for (int n = 0; n < 2; ++n) {
                    const int ch = chb + 16 * n;
                    const size_t off = (size_t)(row0 + ai * HALF + m * 16) * 1536 + ch;
                    const u32x2 xw = *(const u32x2*)(xc + off);
                    const f32x4 ar = acc[ai][0][m][n] + *(const f32x4*)(br + ch), aiv = acc[ai][1][m][n] + *(const f32x4*)(bi + ch);
                    u32x4 w;
                    w.x = cvt_pk_bf16(fast_sigmoid(ar[0]), fast_sigmoid(aiv[0]) * bflo(xw.x));
                    w.y = cvt_pk_bf16(fast_sigmoid(ar[1]), fast_sigmoid(aiv[1]) * bfhi(xw.x));
                    w.z = cvt_pk_bf16(fast_sigmoid(ar[2]), fast_sigmoid(aiv[2]) * bflo(xw.y));
                    w.w = cvt_pk_bf16(fast_sigmoid(ar[3]), fast_sigmoid(aiv[3]) * bfhi(xw.y));
                    *(u32x4*)(RU + off) = w;
                }
                asm volatile("" ::: "memory");
            }
    }
};
__device__ __forceinline__ void st4bf(bf16_t* p, f32x4 v) { u32x2 w; w.x = cvt_pk_bf16(v[0], v[1]); w.y = cvt_pk_bf16(v[2], v[3]); *(u32x2*)p = w; }
struct EpiB1 {
    static constexpr bool PERM = false;
    bf16_t *cq, *qm, *ckv, *kpe; float *ssq_cq, *ssq_lat; const float *rs, *cosT, *sinT;
    __device__ __forceinline__ void operator()(const f32x4 (&acc)[2][2][4][2], const pg8::Unit& u, int wr, int wc, int fr, int fq) const {
        const int row0 = u.pm * 256 + wr * 64 + fr, pn = u.pn;
        if (pn == 7) {
            if (wc < 2) {
                const int j = 16 * wc + 4 * fq;
#pragma unroll
                for (int ai = 0; ai < 2; ++ai)
#pragma unroll
                    for (int m = 0; m < 4; ++m) {
                        const int row = row0 + ai * HALF + m * 16; const float s = rsqrtf(rs[row] * (1.f / DM) + EPS);
                        const f32x4 c4 = *(const f32x4*)(cosT + (size_t)row * 32 + j), s4 = *(const f32x4*)(sinT + (size_t)row * 32 + j);
                        const f32x4 x1 = acc[ai][0][m][0] * s, x2 = acc[ai][0][m][1] * s;
                        st4bf(kpe + (size_t)row * 64 + j, x1 * c4 - x2 * s4); st4bf(kpe + (size_t)row * 64 + j + 32, x2 * c4 + x1 * s4);
                    }
            }
            return;
        }
        bf16_t* O; int ldc, ocol; float cs; float* ssq;
        if (pn < 3) { O = cq; ldc = 768; ocol = pn * 256; cs = 1.f; ssq = ssq_cq; }
        else if (pn < 5) { O = qm; ldc = 512; ocol = (pn - 3) * 256; cs = MEMSCALE; ssq = nullptr; }
        else { O = ckv; ldc = 512; ocol = (pn - 5) * 256; cs = 1.f; ssq = ssq_lat; }
        ocol += wc * 32 + 4 * fq;
#pragma unroll
        for (int ai = 0; ai < 2; ++ai)
#pragma unroll
            for (int m = 0; m < 4; ++m) {
                const int row = row0 + ai * HALF + m * 16; const float s = rsqrtf(rs[row] * (1.f / DM) + EPS) * cs; float part = 0.f;
#pragma unroll
                for (int bj = 0; bj < 2; ++bj)
#pragma unroll
                    for (int n = 0; n < 2; ++n) { const f32x4 v = acc[ai][bj][m][n] * s; part += (v[0] * v[0] + v[1] * v[1]) + (v[2] * v[2] + v[3] * v[3]);
                        st4bf(O + (size_t)row * ldc + ocol + bj * HALF + 16 * n, v); }
                if (ssq) { part += __shfl_xor(part, 16); part += __shfl_xor(part, 32); if (fq == 0) atomicAdd(ssq + row, part); }
            }
    }
};
struct EpiQ {
    static constexpr bool PERM = false;
    bf16_t* Q; const float *ssq, *cosT, *sinT;
    __device__ __forceinline__ void operator()(const f32x4 (&acc)[2][2][4][2], const pg8::Unit& u, int wr, int wc, int fr, int fq) const {
        const int row0 = u.pm * 256 + wr * 64 + fr;
#pragma unroll
        for (int ai = 0; ai < 2; ++ai)
#pragma unroll
            for (int m = 0; m < 4; ++m) {
                const int row = row0 + ai * HALF + m * 16; const float s = rsqrtf(ssq[row] * (1.f / 768.f) + EPS) * QSCALE;
#pragma unroll
                for (int bj = 0; bj < 2; ++bj) {
                    const int g64 = 4 * u.pn + 2 * bj + (wc >> 1), head = g64 / 3, part = g64 - head * 3;
                    if (part < 2) {
#pragma unroll
                        for (int n = 0; n < 2; ++n) st4bf(Q + (size_t)row * 2304 + u.pn * 256 + bj * HALF + wc * 32 + 16 * n + 4 * fq, acc[ai][bj][m][n] * s);
                    } else {
                        const int j = 16 * (wc & 1) + 4 * fq;
                        const f32x4 c4 = *(const f32x4*)(cosT + (size_t)row * 32 + j), s4 = *(const f32x4*)(sinT + (size_t)row * 32 + j);
                        const f32x4 x1 = acc[ai][bj][m][0] * s, x2 = acc[ai][bj][m][1] * s;
                        bf16_t* qp = Q + (size_t)row * 2304 + head * 192 + 128 + j;
                        st4bf(qp, x1 * c4 - x2 * s4); st4bf(qp + 32, x2 * c4 + x1 * s4);
                    }
                }
            }
    }
};

template <bool BASE_F32, bool OUT_F32> struct EpiNorm {
    static constexpr bool PERM = true;
    const float* baseF; bf16_t* HBio; float* outF; const float* g; float* ssqY; float* ssqH; unsigned* cnt; int row_off; LAS float* P;
    __device__ __forceinline__ void operator()(const f32x4 (&acc)[2][2][4][2], const pg8::Unit& u, int wr, int wc, int fr_, int fq_) const {
        int fr = fr_, fq = fq_; asm volatile("" : "+v"(fr), "+v"(fq));
        const int tid = (wr * 4 + wc) * 64 + fq * 16 + fr;
        const int prow = row_off + u.pm * 256;
        const int lrow = wr * 64 + fr, col0 = u.pn * 256 + wc * 32 + 8 * fq;
        u32x4 bw[2][2];
        if (!BASE_F32) {
#pragma unroll
            for (int i = 0; i < 2; ++i)
#pragma unroll
                for (int bj = 0; bj < 2; ++bj) bw[i][bj] = *(const u32x4*)(HBio + (size_t)(prow + lrow + i * 16) * DM + col0 + bj * HALF);
        }
#pragma unroll
        for (int ai = 0; ai < 2; ++ai)
#pragma unroll
            for (int m = 0; m < 4; ++m) { float p = 0.f;
#pragma unroll
                for (int bj = 0; bj < 2; ++bj)
#pragma unroll
                    for (int n = 0; n < 2; ++n) { const f32x4 v = acc[ai][bj][m][n]; p += (v[0] * v[0] + v[1] * v[1]) + (v[2] * v[2] + v[3] * v[3]); }
                p += __shfl_xor(p, 16); p += __shfl_xor(p, 32);
                if (fq == 0) P[(ai * HALF + wr * 64 + m * 16 + fr) * 4 + wc] = p; }
        asm volatile("s_waitcnt lgkmcnt(0)" ::: "memory"); __builtin_amdgcn_s_barrier(); asm volatile("" ::: "memory");
        if (tid < 256) { const float s = (P[tid * 4 + 0] + P[tid * 4 + 1]) + (P[tid * 4 + 2] + P[tid * 4 + 3]);
            (void)__hip_atomic_fetch_add(ssqY + prow + tid, s, __ATOMIC_RELAXED, __HIP_MEMORY_SCOPE_AGENT); }
        asm volatile("s_waitcnt vmcnt(0) lgkmcnt(0)" ::: "memory"); __builtin_amdgcn_s_barrier(); asm volatile("" ::: "memory");
        if (tid == 0) { unsigned* c = cnt + 64 * ((row_off >> 8) + u.pm);
            (void)__hip_atomic_fetch_add(c, 1u, __ATOMIC_RELEASE, __HIP_MEMORY_SCOPE_AGENT);
            unsigned sp = 0; while (__hip_atomic_load(c, __ATOMIC_RELAXED, __HIP_MEMORY_SCOPE_AGENT) < 8u) { __builtin_amdgcn_s_sleep(1); if (++sp > (1u << 22)) break; }
            __builtin_amdgcn_fence(__ATOMIC_ACQUIRE, "agent");
            asm volatile("s_waitcnt vmcnt(0)" ::: "memory"); }
        __builtin_amdgcn_s_barrier(); asm volatile("" ::: "memory");
        float ry[8];
#pragma unroll
        for (int i = 0; i < 8; ++i) ry[i] = __hip_atomic_load(ssqY + prow + lrow + (i >> 2) * HALF + (i & 3) * 16, __ATOMIC_RELAXED, __HIP_MEMORY_SCOPE_AGENT);
        f32x4 gv[2][2];
#pragma unroll
        for (int bj = 0; bj < 2; ++bj) { gv[bj][0] = *(const f32x4*)(g + col0 + bj * HALF); gv[bj][1] = *(const f32x4*)(g + col0 + bj * HALF + 4); }
        asm volatile("s_waitcnt vmcnt(0)" ::: "memory");
#pragma unroll
        for (int i = 0; i < 8; ++i) ry[i] = rsqrtf(ry[i] * (1.f / DM) + EPS);
#pragma unroll
        for (int ai = 0; ai < 2; ++ai)
#pragma unroll
            for (int m = 0; m < 4; ++m) { const float r = ry[ai * 4 + m]; const size_t rowoff = (size_t)(prow + lrow + ai * HALF + m * 16) * DM + col0; float p2 = 0.f;
#pragma unroll
                for (int bj = 0; bj < 2; ++bj) { const size_t off = rowoff + bj * HALF;
                    f32x4 b0, b1;
                    if (BASE_F32) { b0 = *(const f32x4*)(baseF + off); b1 = *(const f32x4*)(baseF + off + 4); }
                    else { u32x4 w; if (m < 2) { w = bw[m][bj]; if (ai == 0) bw[m][bj] = *(const u32x4*)(HBio + off + (size_t)HALF * DM); } else w = *(const u32x4*)(HBio + off); b0 = (f32x4){bflo(w.x), bfhi(w.x), bflo(w.y), bfhi(w.y)}; b1 = (f32x4){bflo(w.z), bfhi(w.z), bflo(w.w), bfhi(w.w)}; }
                    const f32x4 h0 = b0 + acc[ai][bj][m][0] * r * gv[bj][0], h1 = b1 + acc[ai][bj][m][1] * r * gv[bj][1];
                    if (OUT_F32) { __builtin_nontemporal_store(h0, (f32x4*)(outF + off)); __builtin_nontemporal_store(h1, (f32x4*)(outF + off + 4)); }
                    else { p2 += (h0[0] * h0[0] + h0[1] * h0[1]) + (h0[2] * h0[2] + h0[3] * h0[3]) + (h1[0] * h1[0] + h1[1] * h1[1]) + (h1[2] * h1[2] + h1[3] * h1[3]);
                        u32x4 o; o.x = cvt_pk_bf16(h0[0], h0[1]); o.y = cvt_pk_bf16(h0[2], h0[3]); o.z = cvt_pk_bf16(h1[0], h1[1]); o.w = cvt_pk_bf16(h1[2], h1[3]); *(u32x4*)(HBio + off) = o; } }
                if (!OUT_F32) { p2 += __shfl_xor(p2, 16); p2 += __shfl_xor(p2, 32); if (fq == 0) P[(ai * HALF + wr * 64 + m * 16 + fr) * 4 + wc] = p2; }
                asm volatile("" ::: "memory"); }
        asm volatile("s_waitcnt lgkmcnt(0)" ::: "memory"); __builtin_amdgcn_s_barrier(); asm volatile("" ::: "memory");
        if (!OUT_F32) { if (tid < 256) { const float s = (P[tid * 4 + 0] + P[tid * 4 + 1]) + (P[tid * 4 + 2] + P[tid * 4 + 3]);
            (void)__hip_atomic_fetch_add(ssqH + prow + tid, s, __ATOMIC_RELAXED, __HIP_MEMORY_SCOPE_AGENT); } }
    }
};

constexpr int SHM_V = 16384, SHM_K = 24576, ATT_SCR = 2 * SHM_V + 2 * SHM_K;
__device__ __forceinline__ int v_st(int k, int c) { const int kk = (k & ~0xC) | ((k & 4) << 1) | ((k & 8) >> 1); return ((kk >> 3) * 4 + (c >> 5)) * 512 + ((kk & 7) * 32 + (c & 31)) * 2; }
__device__ __forceinline__ int v_rd_base(int lane) { return ((lane & 3) << 3) | (((lane >> 2) & 3) << 6) | (((lane >> 4) & 1) << 5) | (((lane >> 5) & 1) << 8); }
__device__ __forceinline__ int crow(int r, int hi) { return (r & 3) + 8 * (r >> 2) + 4 * hi; }
#define SBAR() __builtin_amdgcn_sched_barrier(0)

struct AttnArgs { const bf16_t* Q; int ldq; const bf16_t* Kn; int ldk; const bf16_t* Kp; const bf16_t* V; int ldv; bf16_t* O; int ldo; int ntiles; int cb; };

__device__ __forceinline__ void att_partialSM(f32x16& p0, f32x16& p1, float& m_reg, float& alpha) {
    float pmax = p0[0];
#pragma unroll
    for (int r = 1; r < 16; ++r) pmax = fmaxf(pmax, p0[r]);
#pragma unroll
    for (int r = 0; r < 16; ++r) pmax = fmaxf(pmax, p1[r]);
    { auto rr = __builtin_amdgcn_permlane32_swap(__float_as_uint(pmax), __float_as_uint(pmax), false, false);
      pmax = fmaxf(__uint_as_float(rr[0]), __uint_as_float(rr[1])); }
    float mn;
    if (__all((pmax - m_reg) <= 11.f)) { mn = m_reg; alpha = 1.f; }
    else { mn = fmaxf(m_reg, pmax); alpha = __builtin_amdgcn_exp2f(m_reg - mn); m_reg = mn; }
#pragma unroll
    for (int r = 0; r < 16; ++r) { p0[r] = __builtin_amdgcn_exp2f(p0[r] - mn); p1[r] = __builtin_amdgcn_exp2f(p1[r] - mn); }
}
__device__ __forceinline__ void att_finishSM(const f32x16& p0, const f32x16& p1, float alpha, float& l_reg, bf16x8& pa0, bf16x8& pa1, bf16x8& pa2, bf16x8& pa3) {
    float ps = 0.f;
#pragma unroll
    for (int r = 0; r < 16; ++r) ps += p0[r] + p1[r];
    { auto rr = __builtin_amdgcn_permlane32_swap(__float_as_uint(ps), __float_as_uint(ps), false, false);
      ps = __uint_as_float(rr[0]) + __uint_as_float(rr[1]); }
    l_reg = l_reg * alpha + ps;
#define PK4(P, B_, OUT) do { unsigned a0 = cvt_pk_bf16(P[B_+0], P[B_+1]), a1 = cvt_pk_bf16(P[B_+2], P[B_+3]);                          \
        unsigned b0 = cvt_pk_bf16(P[B_+4], P[B_+5]), b1 = cvt_pk_bf16(P[B_+6], P[B_+7]);                                             \
        auto r0 = __builtin_amdgcn_permlane32_swap(a0, b0, false, false); auto r1 = __builtin_amdgcn_permlane32_swap(a1, b1, false, false); \
        u32x4 w = {r0[0], r1[0], r0[1], r1[1]}; OUT = *reinterpret_cast<bf16x8*>(&w); } while (0)
    PK4(p0, 0, pa0); PK4(p0, 8, pa1); PK4(p1, 0, pa2); PK4(p1, 8, pa3);
#undef PK4
}
template <int KB, int NKC>
__device__ __forceinline__ void att_qkt(f32x16& p0, f32x16& p1, const char* K_lds, int r32, int hi, const bf16x8* qr) {
    p0 = f32x16{}; p1 = f32x16{};
    const int x = (r32 >> 1) & 7;
    const char* kb[4];
#pragma unroll
    for (int dd = 0; dd < 4; ++dd) kb[dd] = K_lds + KB * SHM_K + r32 * 128 + (((dd * 2 + hi) ^ x) << 4);
#pragma unroll
    for (int d0 = 0; d0 < NKC; ++d0) { const char* a = kb[d0 & 3] + (d0 >> 2) * 8192;
        const bf16x8 b0 = *reinterpret_cast<const bf16x8*>(a);
        const bf16x8 b1 = *reinterpret_cast<const bf16x8*>(a + 4096);
        p0 = __builtin_amdgcn_mfma_f32_32x32x16_bf16(b0, qr[d0], p0, 0, 0, 0);
        p1 = __builtin_amdgcn_mfma_f32_32x32x16_bf16(b1, qr[d0], p1, 0, 0, 0); }
}
template <int VB>
__device__ __forceinline__ void att_pv(f32x16* o, int vb0, bf16x8 pa0, bf16x8 pa1, bf16x8 pa2, bf16x8 pa3) {
#define TRRD(dst, off) asm volatile("ds_read_b64_tr_b16 %0, %1 offset:%2" : "=&v"(dst) : "v"(vb0), "i"(off) : "memory")
#define PV_D0(d0) do { s16x4 l0, l1, l2, l3, h0, h1, h2, h3; constexpr int b_ = VB * SHM_V + (d0) * 512; \
        TRRD(l0, b_); TRRD(h0, b_ + 2048); TRRD(l1, b_ + 4096); TRRD(h1, b_ + 6144); TRRD(l2, b_ + 8192); TRRD(h2, b_ + 10240); TRRD(l3, b_ + 12288); TRRD(h3, b_ + 14336); \
        asm volatile("s_waitcnt lgkmcnt(0)" ::: "memory"); SBAR(); \
        o[d0] = __builtin_amdgcn_mfma_f32_32x32x16_bf16(pa0, (bf16x8){l0[0], l0[1], l0[2], l0[3], h0[0], h0[1], h0[2], h0[3]}, o[d0], 0, 0, 0);   \
        o[d0] = __builtin_amdgcn_mfma_f32_32x32x16_bf16(pa1, (bf16x8){l1[0], l1[1], l1[2], l1[3], h1[0], h1[1], h1[2], h1[3]}, o[d0], 0, 0, 0);   \
        o[d0] = __builtin_amdgcn_mfma_f32_32x32x16_bf16(pa2, (bf16x8){l2[0], l2[1], l2[2], l2[3], h2[0], h2[1], h2[2], h2[3]}, o[d0], 0, 0, 0);   \
        o[d0] = __builtin_amdgcn_mfma_f32_32x32x16_bf16(pa3, (bf16x8){l3[0], l3[1], l3[2], l3[3], h3[0], h3[1], h3[2], h3[3]}, o[d0], 0, 0, 0); } while (0)
    PV_D0(0); PV_D0(1); PV_D0(2); PV_D0(3);
#undef PV_D0
#undef TRRD
}

template <int NKC>
__device__ __forceinline__ void attn_unit(const AttnArgs& a, char* lds) {
    constexpr bool PE = NKC > 8;
    int tid_ = threadIdx.x; asm volatile("" : "+v"(tid_));
    const int tid = tid_, wid = __builtin_amdgcn_readfirstlane(tid >> 6), lane = tid & 63, r32 = lane & 31, hi = lane >> 5;
    char* V_lds = lds; char* K_lds = lds + 2 * SHM_V;
    float* wsf = (float*)(lds + ATT_SCR) + wid * 64; float* li_l = wsf; float* al_l = wsf + 32;
    const int sr = tid >> 4, c16 = tid & 15, sc = c16 * 8;
    const int vst0 = v_st(sr, sc), vst1 = v_st(32 + sr, sc);
    const int kws = (c16 >> 3) * 8192 + sr * 128 + (((c16 & 7) ^ ((sr >> 1) & 7)) << 4);
    const int pkey = tid >> 3, pws = 16384 + pkey * 128 + (((tid & 7) ^ ((pkey >> 1) & 7)) << 4);
    const int vb0 = (int)(uintptr_t)V_lds + v_rd_base(lane);
    const int mytiles = min(a.ntiles, a.cb + (wid >> 1) + 1);
    bf16x8 qr[NKC];
#pragma unroll
    for (int d0 = 0; d0 < NKC; ++d0) qr[d0] = *(const bf16x8*)(a.Q + (size_t)(wid * 32 + r32) * a.ldq + d0 * 16 + hi * 8);
    bf16x8 st_k0, st_k1, st_v0, st_v1, st_p;
#define ALOAD(t) do { const size_t k0_ = (size_t)(t) * 64; \
        st_k0 = *(const bf16x8*)(a.Kn + (k0_ + sr) * a.ldk + sc); st_k1 = *(const bf16x8*)(a.Kn + (k0_ + 32 + sr) * a.ldk + sc); \
        st_v0 = *(const bf16x8*)(a.V + (k0_ + sr) * a.ldv + sc); st_v1 = *(const bf16x8*)(a.V + (k0_ + 32 + sr) * a.ldv + sc); \
        if constexpr (PE) st_p = *(const bf16x8*)(a.Kp + (k0_ + pkey) * 64 + (tid & 7) * 8); } while (0)
#define AWRITE(bf) do { *(bf16x8*)(K_lds + (bf) * SHM_K + kws) = st_k0; *(bf16x8*)(K_lds + (bf) * SHM_K + kws + 4096) = st_k1; \
        *(bf16x8*)(V_lds + (bf) * SHM_V + vst0) = st_v0; *(bf16x8*)(V_lds + (bf) * SHM_V + vst1) = st_v1; \
        if constexpr (PE) *(bf16x8*)(K_lds + (bf) * SHM_K + pws) = st_p; } while (0)
    float m_reg = -1e30f, l_reg = 0.f; f32x16 o[4] = {};
    ALOAD(0); AWRITE(0);
    __syncthreads();
#define ATILE(t, BF) do { \
        if ((t) + 1 < a.ntiles) ALOAD((t) + 1); \
        if ((t) < mytiles) { f32x16 p0, p1; float alpha; bf16x8 pa0, pa1, pa2, pa3; \
            att_qkt<BF, NKC>(p0, p1, K_lds, r32, hi, qr); \
            att_partialSM(p0, p1, m_reg, alpha); \
            if (__any(alpha < 1.f)) { if (hi == 0) al_l[r32] = alpha; asm volatile("s_waitcnt lgkmcnt(0)" ::: "memory"); \
                _Pragma("unroll") for (int d_ = 0; d_ < 4; ++d_) _Pragma("unroll") for (int r = 0; r < 16; ++r) o[d_][r] *= al_l[crow(r, hi)]; } \
            att_finishSM(p0, p1, alpha, l_reg, pa0, pa1, pa2, pa3); SBAR(); \
            att_pv<BF>(o, vb0, pa0, pa1, pa2, pa3); } \
        if ((t) + 1 < a.ntiles) AWRITE(1 - (BF)); \
        __syncthreads(); } while (0)
    for (int t = 0; t < a.ntiles; t += 2) {
        ATILE(t, 0);
        if (t + 1 < a.ntiles) ATILE(t + 1, 1);
    }
#undef ATILE
#undef ALOAD
#undef AWRITE
    if (hi == 0) li_l[r32] = l_reg; asm volatile("s_waitcnt lgkmcnt(0)" ::: "memory");
    float rli[16];
#pragma unroll
    for (int r = 0; r < 16; ++r) rli[r] = __builtin_amdgcn_rcpf(li_l[crow(r, hi)]);
    bf16_t* Ow = a.O + (size_t)(wid * 32) * a.ldo;
#pragma unroll
    for (int r = 0; r < 16; ++r) { const int orow = crow(r, hi);
#pragma unroll
        for (int d0 = 0; d0 < 4; ++d0) { const float v = o[d0][r] * rli[r];
            const float vn = __shfl_xor(v, 1);
            if ((r32 & 1) == 0) *(unsigned*)(Ow + (size_t)orow * a.ldo + d0 * 32 + r32) = cvt_pk_bf16(v, vn); } }
    __syncthreads();
}

#define XB_TMO      128
#define XB_XCNT(j)  (256  + 64 * (j))
#define XB_XSUB(j)  (1280 + 64 * (j))
#define XB_XGEN(j)  (2304 + 64 * (j))
#define XB_TOP      3328
#define XB_TOPGEN   3392
#define XCD_BAR_WORDS 3456
#define XB_SPIN_CAP (1u << 18)

__device__ __forceinline__ unsigned xb_ld(unsigned* p)              { return __hip_atomic_load(p, __ATOMIC_RELAXED, __HIP_MEMORY_SCOPE_AGENT); }
__device__ __forceinline__ unsigned xb_add(unsigned* p, unsigned v) { return __hip_atomic_fetch_add(p, v, __ATOMIC_RELAXED, __HIP_MEMORY_SCOPE_AGENT); }
__device__ __forceinline__ unsigned xb_xcc_id() { return (unsigned)__builtin_amdgcn_s_getreg((3 << 11) | 20) & 0xFu; }
#define XB_SPIN(cond, bar) do { unsigned _sp = 0; while (cond) { __builtin_amdgcn_s_sleep(1); \
    if ((++_sp & 255u) == 0u) { if (xb_ld(&(bar)[XB_TMO])) break; if (_sp > XB_SPIN_CAP) { atomicAdd(&(bar)[XB_TMO], 1u); break; } } } } while (0)

struct XcdBarrier {
    unsigned* bar; unsigned x;
    volatile LAS unsigned* st;
};

__device__ __forceinline__ XcdBarrier xcd_barrier_post(unsigned* bar, volatile LAS unsigned* st) {
    XcdBarrier b; b.bar = bar; b.x = xb_xcc_id(); b.st = st;
    if (threadIdx.x == 0) (void)xb_add(&bar[XB_XCNT(b.x)], 1u);
    return b;
}
__device__ __forceinline__ void xcd_barrier_complete(unsigned* bar, unsigned x, unsigned& nloc, unsigned& nx) {
    const unsigned G = gridDim.x * gridDim.y * gridDim.z;
    unsigned sum, cnt, mine, sp = 0u;
    for (;;) {
        sum = 0u; cnt = 0u; mine = 0u;
#pragma unroll
        for (unsigned j = 0; j < 16; ++j) { const unsigned c = xb_ld(&bar[XB_XCNT(j)]); sum += c; cnt += (c > 0u) ? 1u : 0u; mine = (j == x) ? c : mine; }
        if (sum == G) break;
        __builtin_amdgcn_s_sleep(1);
        if ((++sp & 255u) == 0u) { if (xb_ld(&bar[XB_TMO])) break; if (sp > XB_SPIN_CAP) { atomicAdd(&bar[XB_TMO], 1u); break; } }
    }
    nloc = mine > 0u ? mine : 1u; nx = cnt > 0u ? cnt : 1u;
}

__device__ __forceinline__ void xcd_barrier(const XcdBarrier& b) {
    asm volatile("s_waitcnt vmcnt(0)" ::: "memory");
    __syncthreads();
    if (threadIdx.x == 0) {
        unsigned* bar = b.bar;
        __builtin_amdgcn_s_waitcnt(0);
        unsigned nloc = b.st[0], nx = b.st[1];
        if (nloc == 0u) { xcd_barrier_complete(bar, b.x, nloc, nx); b.st[0] = nloc; b.st[1] = nx; }
        const unsigned old = xb_add(&bar[XB_XSUB(b.x)], 1u);
        const unsigned gen = old / nloc;
        if (old + 1u == (gen + 1u) * nloc) {
            __builtin_amdgcn_fence(__ATOMIC_RELEASE, "agent");
            asm volatile("s_waitcnt vmcnt(0)" ::: "memory");
            const unsigned og = xb_add(&bar[XB_TOP], 1u);
            const unsigned tg = og / nx;
            if (og + 1u == (tg + 1u) * nx) xb_add(&bar[XB_TOPGEN], 1u);
            else XB_SPIN(xb_ld(&bar[XB_TOPGEN]) == tg, bar);
            __builtin_amdgcn_fence(__ATOMIC_ACQUIRE, "agent");
            xb_add(&bar[XB_XGEN(b.x)], 1u);
            asm volatile("s_waitcnt vmcnt(0)" ::: "memory");
        } else {
            __builtin_amdgcn_fence(__ATOMIC_ACQUIRE, "agent");
            asm volatile("s_waitcnt vmcnt(0)" ::: "memory");
            XB_SPIN(xb_ld(&bar[XB_XGEN(b.x)]) == gen, bar);
            asm volatile("" ::: "memory");
            if (false) __builtin_amdgcn_fence(__ATOMIC_ACQUIRE, "agent");
            asm volatile("s_waitcnt vmcnt(0)" ::: "memory");
        }
    }
    __syncthreads();
}

constexpr int ATT_SLOTS = 8;
__device__ const unsigned short g_att_sched[256][ATT_SLOTS] = {
{15,518,512,1056,1200,65535,65535,65535},
{31,534,528,1057,1201,65535,65535,65535},
{47,550,544,1058,1202,65535,65535,65535},
{63,566,560,1059,1203,65535,65535,65535},
{79,582,576,1060,1204,65535,65535,65535},
{95,598,592,1061,1205,65535,65535,65535},
{111,614,608,1062,1206,65535,65535,65535},
{127,630,624,1063,1207,65535,65535,65535},
{143,646,640,1064,1208,65535,65535,65535},
{159,662,656,1065,1209,65535,65535,65535},
{175,678,672,1066,1210,65535,65535,65535},
{191,694,688,1067,1211,65535,65535,65535},
{207,710,704,1068,1212,65535,65535,65535},
{223,726,720,1069,1213,65535,65535,65535},
{239,742,736,1070,1214,65535,65535,65535},
{255,758,752,1071,1215,65535,65535,65535},
{271,5,514,1152,65535,65535,65535,65535},
{287,21,530,1153,65535,65535,65535,65535},
{303,37,546,1154,65535,65535,65535,65535},
{319,53,562,1155,65535,65535,65535,65535},
{335,69,578,1156,65535,65535,65535,65535},
{351,85,594,1157,65535,65535,65535,65535},
{367,101,610,1158,65535,65535,65535,65535},
{383,117,626,1159,65535,65535,65535,65535},
{399,133,642,1160,65535,65535,65535,65535},
{415,149,658,1161,65535,65535,65535,65535},
{431,165,674,1162,65535,65535,65535,65535},
{447,181,690,1163,65535,65535,65535,65535},
{463,197,706,1164,65535,65535,65535,65535},
{479,213,722,1165,65535,65535,65535,65535},
{495,229,738,1166,65535,65535,65535,65535},
{511,245,754,1167,65535,65535,65535,65535},
{527,261,1,1072,1216,65535,65535,65535},
{543,277,17,1073,1217,65535,65535,65535},
{559,293,33,1074,1218,65535,65535,65535},
{575,309,49,1075,1219,65535,65535,65535},
{591,325,65,1076,1220,65535,65535,65535},
{607,341,81,1077,1221,65535,65535,65535},
{623,357,97,1078,1222,65535,65535,65535},
{639,373,113,1079,1223,65535,65535,65535},
{655,389,129,1080,1224,65535,65535,65535},
{671,405,145,1081,1225,65535,65535,65535},
{687,421,161,1082,1226,65535,65535,65535},
{703,437,177,1083,1227,65535,65535,65535},
{719,453,193,1084,1228,65535,65535,65535},
{735,469,209,1085,1229,65535,65535,65535},
{751,485,225,1086,1230,65535,65535,65535},
{767,501,241,1087,1231,65535,65535,65535},
{14,519,257,1088,65535,65535,65535,65535},
{30,535,273,1089,65535,65535,65535,65535},
{46,551,289,1090,65535,65535,65535,65535},
{62,567,305,1091,65535,65535,65535,65535},
{78,583,321,1092,65535,65535,65535,65535},
{94,599,337,1093,65535,65535,65535,65535},
{110,615,353,1094,65535,65535,65535,65535},
{126,631,369,1095,65535,65535,65535,65535},
{142,647,385,1096,65535,65535,65535,65535},
{158,663,401,1097,65535,65535,65535,65535},
{174,679,417,1098,65535,65535,65535,65535},
{190,695,433,1099,65535,65535,65535,65535},
{206,711,449,1100,65535,65535,65535,65535},
{222,727,465,1101,65535,65535,65535,65535},
{238,743,481,1102,65535,65535,65535,65535},
{254,759,497,1103,65535,65535,65535,65535},
{13,6,517,65535,65535,65535,65535,65535},
{29,22,533,65535,65535,65535,65535,65535},
{45,38,549,65535,65535,65535,65535,65535},
{61,54,565,65535,65535,65535,65535,65535},
{77,70,581,65535,65535,65535,65535,65535},
{93,86,597,65535,65535,65535,65535,65535},
{109,102,613,65535,65535,65535,65535,65535},
{125,118,629,65535,65535,65535,65535,65535},
{141,134,645,65535,65535,65535,65535,65535},
{157,150,661,65535,65535,65535,65535,65535},
{173,166,677,65535,65535,65535,65535,65535},
{189,182,693,65535,65535,65535,65535,65535},
{205,198,709,65535,65535,65535,65535,65535},
{221,214,725,65535,65535,65535,65535,65535},
{237,230,741,65535,65535,65535,65535,65535},
{253,246,757,65535,65535,65535,65535,65535},
{526,262,4,65535,65535,65535,65535,65535},
{542,278,20,65535,65535,65535,65535,65535},
{558,294,36,65535,65535,65535,65535,65535},
{574,310,52,65535,65535,65535,65535,65535},
{590,326,68,65535,65535,65535,65535,65535},
{606,342,84,65535,65535,65535,65535,65535},
{622,358,100,65535,65535,65535,65535,65535},
{638,374,116,65535,65535,65535,65535,65535},
{654,390,132,65535,65535,65535,65535,65535},
{670,406,148,65535,65535,65535,65535,65535},
{686,422,164,65535,65535,65535,65535,65535},
{702,438,180,65535,65535,65535,65535,65535},
{718,454,196,65535,65535,65535,65535,65535},
{734,470,212,65535,65535,65535,65535,65535},
{750,486,228,65535,65535,65535,65535,65535},
{766,502,244,65535,65535,65535,65535,65535},
{270,520,513,1104,65535,65535,65535,65535},
{286,536,529,1105,65535,65535,65535,65535},
{302,552,545,1106,65535,65535,65535,65535},
{318,568,561,1107,65535,65535,65535,65535},
{334,584,577,1108,65535,65535,65535,65535},
{350,600,593,1109,65535,65535,65535,65535},
{366,616,609,1110,65535,65535,65535,65535},
{382,632,625,1111,65535,65535,65535,65535},
{398,648,641,1112,65535,65535,65535,65535},
{414,664,657,1113,65535,65535,65535,65535},
{430,680,673,1114,65535,65535,65535,65535},
{446,696,689,1115,65535,65535,65535,65535},
{462,712,705,1116,65535,65535,65535,65535},
{478,728,721,1117,65535,65535,65535,65535},
{494,744,737,1118,65535,65535,65535,65535},
{510,760,753,1119,65535,65535,65535,65535},
{269,7,260,65535,65535,65535,65535,65535},
{285,23,276,65535,65535,65535,65535,65535},
{301,39,292,65535,65535,65535,65535,65535},
{317,55,308,65535,65535,65535,65535,65535},
{333,71,324,65535,65535,65535,65535,65535},
{349,87,340,65535,65535,65535,65535,65535},
{365,103,356,65535,65535,65535,65535,65535},
{381,119,372,65535,65535,65535,65535,65535},
{397,135,388,65535,65535,65535,65535,65535},
{413,151,404,65535,65535,65535,65535,65535},
{429,167,420,65535,65535,65535,65535,65535},
{445,183,436,65535,65535,65535,65535,65535},
{461,199,452,65535,65535,65535,65535,65535},
{477,215,468,65535,65535,65535,65535,65535},
{493,231,484,65535,65535,65535,65535,65535},
{509,247,500,65535,65535,65535,65535,65535},
{525,263,516,65535,65535,65535,65535,65535},
{541,279,532,65535,65535,65535,65535,65535},
{557,295,548,65535,65535,65535,65535,65535},
{573,311,564,65535,65535,65535,65535,65535},
{589,327,580,65535,65535,65535,65535,65535},
{605,343,596,65535,65535,65535,65535,65535},
{621,359,612,65535,65535,65535,65535,65535},
{637,375,628,65535,65535,65535,65535,65535},
{653,391,644,65535,65535,65535,65535,65535},
{669,407,660,65535,65535,65535,65535,65535},
{685,423,676,65535,65535,65535,65535,65535},
{701,439,692,65535,65535,65535,65535,65535},
{717,455,708,65535,65535,65535,65535,65535},
{733,471,724,65535,65535,65535,65535,65535},
{749,487,740,65535,65535,65535,65535,65535},
{765,503,756,65535,65535,65535,65535,65535},
{12,521,0,1024,1168,65535,65535,65535},
{28,537,16,1025,1169,65535,65535,65535},
{44,553,32,1026,1170,65535,65535,65535},
{60,569,48,1027,1171,65535,65535,65535},
{76,585,64,1028,1172,65535,65535,65535},
{92,601,80,1029,1173,65535,65535,65535},
{108,617,96,1030,1174,65535,65535,65535},
{124,633,112,1031,1175,65535,65535,65535},
{140,649,128,1032,1176,65535,65535,65535},
{156,665,144,1033,1177,65535,65535,65535},
{172,681,160,1034,1178,65535,65535,65535},
{188,697,176,1035,1179,65535,65535,65535},
{204,713,192,1036,1180,65535,65535,65535},
{220,729,208,1037,1181,65535,65535,65535},
{236,745,224,1038,1182,65535,65535,65535},
{252,761,240,1039,1183,65535,65535,65535},
{268,8,3,1232,65535,65535,65535,65535},
{284,24,19,1233,65535,65535,65535,65535},
{300,40,35,1234,65535,65535,65535,65535},
{316,56,51,1235,65535,65535,65535,65535},
{332,72,67,1236,65535,65535,65535,65535},
{348,88,83,1237,65535,65535,65535,65535},
{364,104,99,1238,65535,65535,65535,65535},
{380,120,115,1239,65535,65535,65535,65535},
{396,136,131,1240,65535,65535,65535,65535},
{412,152,147,1241,65535,65535,65535,65535},
{428,168,163,1242,65535,65535,65535,65535},
{444,184,179,1243,65535,65535,65535,65535},
{460,200,195,1244,65535,65535,65535,65535},
{476,216,211,1245,65535,65535,65535,65535},
{492,232,227,1246,65535,65535,65535,65535},
{508,248,243,1247,65535,65535,65535,65535},
{524,264,259,1248,65535,65535,65535,65535},
{540,280,275,1249,65535,65535,65535,65535},
{556,296,291,1250,65535,65535,65535,65535},
{572,312,307,1251,65535,65535,65535,65535},
{588,328,323,1252,65535,65535,65535,65535},
{604,344,339,1253,65535,65535,65535,65535},
{620,360,355,1254,65535,65535,65535,65535},
{636,376,371,1255,65535,65535,65535,65535},
{652,392,387,1256,65535,65535,65535,65535},
{668,408,403,1257,65535,65535,65535,65535},
{684,424,419,1258,65535,65535,65535,65535},
{700,440,435,1259,65535,65535,65535,65535},
{716,456,451,1260,65535,65535,65535,65535},
{732,472,467,1261,65535,65535,65535,65535},
{748,488,483,1262,65535,65535,65535,65535},
{764,504,499,1263,65535,65535,65535,65535},
{11,522,256,1040,1184,65535,65535,65535},
{27,538,272,1041,1185,65535,65535,65535},
{43,554,288,1042,1186,65535,65535,65535},
{59,570,304,1043,1187,65535,65535,65535},
{75,586,320,1044,1188,65535,65535,65535},
{91,602,336,1045,1189,65535,65535,65535},
{107,618,352,1046,1190,65535,65535,65535},
{123,634,368,1047,1191,65535,65535,65535},
{139,650,384,1048,1192,65535,65535,65535},
{155,666,400,1049,1193,65535,65535,65535},
{171,682,416,1050,1194,65535,65535,65535},
{187,698,432,1051,1195,65535,65535,65535},
{203,714,448,1052,1196,65535,65535,65535},
{219,730,464,1053,1197,65535,65535,65535},
{235,746,480,1054,1198,65535,65535,65535},
{251,762,496,1055,1199,65535,65535,65535},
{267,9,515,1264,65535,65535,65535,65535},
{283,25,531,1265,65535,65535,65535,65535},
{299,41,547,1266,65535,65535,65535,65535},
{315,57,563,1267,65535,65535,65535,65535},
{331,73,579,1268,65535,65535,65535,65535},
{347,89,595,1269,65535,65535,65535,65535},
{363,105,611,1270,65535,65535,65535,65535},
{379,121,627,1271,65535,65535,65535,65535},
{395,137,643,1272,65535,65535,65535,65535},
{411,153,659,1273,65535,65535,65535,65535},
{427,169,675,1274,65535,65535,65535,65535},
{443,185,691,1275,65535,65535,65535,65535},
{459,201,707,1276,65535,65535,65535,65535},
{475,217,723,1277,65535,65535,65535,65535},
{491,233,739,1278,65535,65535,65535,65535},
{507,249,755,1279,65535,65535,65535,65535},
{523,265,2,1120,65535,65535,65535,65535},
{539,281,18,1121,65535,65535,65535,65535},
{555,297,34,1122,65535,65535,65535,65535},
{571,313,50,1123,65535,65535,65535,65535},
{587,329,66,1124,65535,65535,65535,65535},
{603,345,82,1125,65535,65535,65535,65535},
{619,361,98,1126,65535,65535,65535,65535},
{635,377,114,1127,65535,65535,65535,65535},
{651,393,130,1128,65535,65535,65535,65535},
{667,409,146,1129,65535,65535,65535,65535},
{683,425,162,1130,65535,65535,65535,65535},
{699,441,178,1131,65535,65535,65535,65535},
{715,457,194,1132,65535,65535,65535,65535},
{731,473,210,1133,65535,65535,65535,65535},
{747,489,226,1134,65535,65535,65535,65535},
{763,505,242,1135,65535,65535,65535,65535},
{10,266,258,1136,65535,65535,65535,65535},
{26,282,274,1137,65535,65535,65535,65535},
{42,298,290,1138,65535,65535,65535,65535},
{58,314,306,1139,65535,65535,65535,65535},
{74,330,322,1140,65535,65535,65535,65535},
{90,346,338,1141,65535,65535,65535,65535},
{106,362,354,1142,65535,65535,65535,65535},
{122,378,370,1143,65535,65535,65535,65535},
{138,394,386,1144,65535,65535,65535,65535},
{154,410,402,1145,65535,65535,65535,65535},
{170,426,418,1146,65535,65535,65535,65535},
{186,442,434,1147,65535,65535,65535,65535},
{202,458,450,1148,65535,65535,65535,65535},
{218,474,466,1149,65535,65535,65535,65535},
{234,490,482,1150,65535,65535,65535,65535},
{250,506,498,1151,65535,65535,65535,65535}};

struct Args {
    const float *x, *mem; const int* pos;
    const float *g_mix_pre, *g_mix_post, *g_mlp_pre, *g_mlp_post, *g_mem, *w_mem_k, *w_mem_v, *w_o, *w_ff1, *w_ff2;
    const float *a_w_in, *a_conv_w, *a_conv_b, *a_w_r, *a_b_r, *a_w_i, *a_b_i, *a_lambda;
    const float *b_w_in, *b_g_qa, *b_w_qb, *kv_g_in, *kv_w_down, *kv_g_latent, *kv_w_up;
    float* out; unsigned char* ws;
    float invf[32];
    int ph_lo, ph_hi;
};

__device__ __forceinline__ int rope_pos(int j) { return 32 * ((j >> 4) & 1) + 16 * (j >> 5) + (j & 15); }
__device__ __forceinline__ void tr_load(const float* W, int ldw, int scol0, int ncols, int item, int lane, float (&v)[32]) {
    const int nblk = ncols / 32, kb = item / nblk, nb = item - kb * nblk, k0 = 64 * kb, n0 = 32 * nb;
    const float* wp = W + (size_t)(k0 + (lane >> 5)) * ldw + scol0 + n0 + (lane & 31);
#pragma unroll
    for (int i = 0; i < 32; ++i) v[i] = __builtin_nontemporal_load(wp + (size_t)(2 * i) * ldw);
}
__device__ __forceinline__ void tr_store(const float (&v)[32], int ncols, const float* gain, bf16_t* WT, int ldk, int koff, int kind, int rbase, LAS float* scr, int item, int lane, bool far = false) {
    const int nblk = ncols / 32, kb = item / nblk, nb = item - kb * nblk, k0 = 64 * kb, n0 = 32 * nb;
    const int c = lane & 7;
    f32x4 g0 = {1.f, 1.f, 1.f, 1.f}, g1 = g0;
    if (gain) { g0 = *(const f32x4*)(gain + k0 + 8 * c); g1 = *(const f32x4*)(gain + k0 + 8 * c + 4); }
#pragma unroll
    for (int i = 0; i < 32; ++i) scr[(2 * i + (lane >> 5)) * 33 + (lane & 31)] = v[i];
    asm volatile("s_waitcnt lgkmcnt(0)" ::: "memory");
#pragma unroll
    for (int j = 0; j < 4; ++j) { const int n = (lane >> 3) + 8 * j; const LAS float* s = scr + (8 * c) * 33 + n;
        u32x4 o; o.x = cvt_pk_bf16(s[0 * 33] * g0[0], s[1 * 33] * g0[1]); o.y = cvt_pk_bf16(s[2 * 33] * g0[2], s[3 * 33] * g0[3]);
        o.z = cvt_pk_bf16(s[4 * 33] * g1[0], s[5 * 33] * g1[1]); o.w = cvt_pk_bf16(s[6 * 33] * g1[2], s[7 * 33] * g1[3]);
        const int nn = n0 + n; int drow;
        if (kind == 0) drow = rbase + nn;
        else if (kind == 1) { const int head = nn / 192, w = nn - head * 192; drow = head * 192 + (w >= 128 ? 128 + rope_pos(w - 128) : w); }
        else drow = rbase + rope_pos(nn);
        if (far) __builtin_nontemporal_store(o, (u32x4*)(WT + (size_t)drow * ldk + koff + k0 + 8 * c)); else *(u32x4*)(WT + (size_t)drow * ldk + koff + k0 + 8 * c) = o; }
    asm volatile("s_waitcnt lgkmcnt(0)" ::: "memory");
}
__device__ __forceinline__ void tr_job(int& it, int stride, const float* W, int ldw, int scol0, int ncols, int K, const float* gain, bf16_t* WT, int ldk, int koff, int kind, int rbase, LAS float* scr, int lane, bool far = false) {
    const int ni = (K / 64) * (ncols / 32);
    if (it < ni) { float v[32]; tr_load(W, ldw, scol0, ncols, it, lane, v);
        for (;;) { const int nx = it + stride; float w[32];
            if (nx < ni) tr_load(W, ldw, scol0, ncols, nx, lane, w);
            tr_store(v, ncols, gain, WT, ldk, koff, kind, rbase, scr, it, lane, far);
            it = nx; if (nx >= ni) break;
#pragma unroll
            for (int i = 0; i < 32; ++i) v[i] = w[i]; } }
    it -= ni;
}
__device__ __forceinline__ void cvt_rows(const float* src, bf16_t* dst, float* rstd, int nrows, int gw, int NGW, int lane) {
    for (int row = gw; row < nrows; row += NGW) {
        const float* xr = src + (size_t)row * DM; float ss = 0.f;
#pragma unroll
        for (int j = 0; j < 4; ++j) { const int col = (lane + 64 * j) * 8; const f32x4 a = *(const f32x4*)(xr + col), b = *(const f32x4*)(xr + col + 4);
            ss += (a[0] * a[0] + a[1] * a[1]) + (a[2] * a[2] + a[3] * a[3]) + (b[0] * b[0] + b[1] * b[1]) + (b[2] * b[2] + b[3] * b[3]);
            u32x4 w; w.x = cvt_pk_bf16(a[0], a[1]); w.y = cvt_pk_bf16(a[2], a[3]); w.z = cvt_pk_bf16(b[0], b[1]); w.w = cvt_pk_bf16(b[2], b[3]);
            *(u32x4*)(dst + (size_t)row * DM + col) = w; }
        ss = wave_sum(ss);
        if (lane == 0) rstd[row] = rsqrtf(ss * (1.f / DM) + EPS);
    }
}
template <bool BASE_F32, bool OUT_F32>
__device__ __forceinline__ void row_pass(const bf16_t* Y, const float* baseF, const float* g, float* outF, bf16_t* HBio, float* rstd_out, int gw, int NGW, int lane) {
    for (int row = gw; row < T; row += NGW) {
        const u32x4* yr = (const u32x4*)(Y + (size_t)row * DM) + lane;
        u32x4 yw[4]; u32x4 bw[4]; float ss = 0.f;
#pragma unroll
        for (int j = 0; j < 4; ++j) yw[j] = yr[64 * j];
        if (!BASE_F32) {
#pragma unroll
            for (int j = 0; j < 4; ++j) bw[j] = ((const u32x4*)(HBio + (size_t)row * DM) + lane)[64 * j]; }
#pragma unroll
        for (int j = 0; j < 4; ++j) { const u32x4 w = yw[j];
            ss += bflo(w.x) * bflo(w.x) + bfhi(w.x) * bfhi(w.x) + bflo(w.y) * bflo(w.y) + bfhi(w.y) * bfhi(w.y) + bflo(w.z) * bflo(w.z) + bfhi(w.z) * bfhi(w.z) + bflo(w.w) * bflo(w.w) + bfhi(w.w) * bfhi(w.w); }
        ss = wave_sum(ss);
        const float ry = rsqrtf(ss * (1.f / DM) + EPS); float ss2 = 0.f;
#pragma unroll
        for (int j = 0; j < 4; ++j) { const int col = (lane + 64 * j) * 8; const size_t off = (size_t)row * DM + col;
            f32x4 b0, b1;
            if (BASE_F32) { b0 = *(const f32x4*)(baseF + off); b1 = *(const f32x4*)(baseF + off + 4); }
            else { const u32x4 w = bw[j]; b0 = (f32x4){bflo(w.x), bfhi(w.x), bflo(w.y), bfhi(w.y)}; b1 = (f32x4){bflo(w.z), bfhi(w.z), bflo(w.w), bfhi(w.w)}; }
            const f32x4 g0 = *(const f32x4*)(g + col), g1 = *(const f32x4*)(g + col + 4);
            const u32x4 w = yw[j];
            const f32x4 y0 = {bflo(w.x), bfhi(w.x), bflo(w.y), bfhi(w.y)}, y1 = {bflo(w.z), bfhi(w.z), bflo(w.w), bfhi(w.w)};
            const f32x4 h0 = b0 + y0 * ry * g0, h1 = b1 + y1 * ry * g1;
            if (OUT_F32) { *(f32x4*)(outF + off) = h0; *(f32x4*)(outF + off + 4) = h1; }
            else { ss2 += (h0[0] * h0[0] + h0[1] * h0[1]) + (h0[2] * h0[2] + h0[3] * h0[3]) + (h1[0] * h1[0] + h1[1] * h1[1]) + (h1[2] * h1[2] + h1[3] * h1[3]);
                u32x4 o; o.x = cvt_pk_bf16(h0[0], h0[1]); o.y = cvt_pk_bf16(h0[2], h0[3]); o.z = cvt_pk_bf16(h1[0], h1[1]); o.w = cvt_pk_bf16(h1[2], h1[3]); *(u32x4*)(HBio + off) = o; } }
        if (!OUT_F32) { ss2 = wave_sum(ss2); if (lane == 0) rstd_out[row] = rsqrtf(ss2 * (1.f / DM) + EPS); }
    }
}

constexpr int LDS_BYTES = 147456;
constexpr int NPH = 21;

#ifndef PHMASK
#define PHMASK 0xffffffffu
#endif
typedef const __attribute__((address_space(4))) Args* ArgsP;
#define PHASE_BEGIN ArgsP ap = (ArgsP)__builtin_amdgcn_kernarg_segment_ptr(); asm volatile("" : "+s"(ap) :: "memory"); unsigned char* ws = ap->ws; \
    int tid_ = threadIdx.x, bx_ = blockIdx.x; asm volatile("" : "+v"(tid_), "+s"(bx_)); const int tid = tid_, lane = tid & 63, wave = __builtin_amdgcn_readfirstlane(tid >> 6); const int G = gridDim.x, bx = bx_; \
    const int gw = bx * 8 + wave, NGW = G * 8, gt = bx * 512 + tid, NGT = G * 512; (void)lane; (void)gw; (void)NGW; (void)gt; (void)NGT; (void)ws;
using SO = pg8::StaticOrder;
using EN_TF = EpiNorm<true, false>; using EN_FF = EpiNorm<false, false>; using EN_FT = EpiNorm<false, true>;
#define RUN_GEMM(EPI, e, A_, B_, lda_, ldb_, K_, M_, N_, cidx) do { pg8::Gemm g_{A_, B_, lda_, ldb_, K_, 0, 0}; SO S_; S_.init(M_, N_, G, cidx); \
        pg8::gemm_phase<EPI, SO, true, true>(ldsl, g_, S_, e); } while (0)
#define WSP(T_, off) ((T_*)(ws + (off)))

__global__ void __launch_bounds__(512, 2) fwd_mega(Args args_unused) {
    extern __shared__ __attribute__((aligned(16))) unsigned char lds[];
    LAS unsigned char* ldsl = (LAS unsigned char*)lds;
    volatile LAS unsigned* bst = (volatile LAS unsigned*)(ldsl + 131072 + 64);
    if (threadIdx.x < 4) bst[threadIdx.x] = 0u;
    __syncthreads();
    { ArgsP ap0 = (ArgsP)__builtin_amdgcn_kernarg_segment_ptr(); (void)xcd_barrier_post((unsigned*)(ap0->ws + WS_BAR), bst); }
#define SEAM() do { ArgsP apb_ = (ArgsP)__builtin_amdgcn_kernarg_segment_ptr(); asm volatile("" : "+s"(apb_) :: "memory"); XcdBarrier b_; b_.bar = (unsigned*)(apb_->ws + WS_BAR); b_.x = xb_xcc_id(); b_.st = bst; xcd_barrier(b_); } while (0)

    if ((PHMASK >> 0) & 1) { PHASE_BEGIN
        float* ssq_cq = WSP(float, WS_SSQCQ); float* ssq_lat = WSP(float, WS_SSQLAT); float* cosT = WSP(float, WS_COS); float* sinT = WSP(float, WS_SIN);
        for (int i = gt; i < T; i += NGT) { ssq_cq[i] = 0.f; ssq_lat[i] = 0.f; }
        for (int i = gt; i < (int)((WS_CTL_ZERO_END - WS_SSQY) / 4); i += NGT) ((unsigned*)(ws + WS_SSQY))[i] = 0u;
        { const int* pos = ap->pos;
        for (int i = gt; i < T * 32; i += NGT) { const int t = i >> 5, f = i & 31; const float ang = (float)pos[t] * ap->invf[f];
            double rev = (double)ang * 0.15915494309189535; rev -= rint(rev); const float rf = (float)rev;
            cosT[i] = __builtin_amdgcn_cosf(rf); sinT[i] = __builtin_amdgcn_sinf(rf); } }
        { u32x4 z = {0u, 0u, 0u, 0u};
          u32x4* p = (u32x4*)(ws + WS_WBIN + (size_t)1856 * 2048 * 2); for (int i = gt; i < 192 * 2048 * 2 / 16; i += NGT) p[i] = z;
          for (int i = gt; i < 3072 * 16; i += NGT) { const int row = i >> 4, c = i & 15; const int pnr = (row >> 8) & 1;
              *(u32x4*)(ws + WS_WGATE + ((size_t)row * 256 + (1 - pnr) * 128) * 2 + c * 16) = z; } }
        cvt_rows(ap->x, WSP(bf16_t, WS_HB), WSP(float, WS_RSTD), T, gw, NGW, lane);
        cvt_rows(ap->mem, WSP(bf16_t, WS_MEMB), WSP(float, WS_RSTDMEM), 1024, gw, NGW, lane);
        LAS float* scr = (LAS float*)(ldsl + wave * 16384);
        int it = gw;
#define JOB(W_, ldw_, scol_, ncols_, K_, gain_, dst_, ldk_, koff_, kind_, rbase_) tr_job(it, NGW, W_, ldw_, scol_, ncols_, K_, gain_, (bf16_t*)(ws + (dst_)), ldk_, koff_, kind_, rbase_, scr, lane);
#define JOBF(W_, ldw_, scol_, ncols_, K_, gain_, dst_, ldk_, koff_, kind_, rbase_) tr_job(it, NGW, W_, ldw_, scol_, ncols_, K_, gain_, (bf16_t*)(ws + (dst_)), ldk_, koff_, kind_, rbase_, scr, lane, true);
        JOB(ap->a_w_in, 3584, 0, 3584, 2048, ap->g_mix_pre, WS_WAIN, 2048, 0, 0, 0)
        JOB(ap->w_o, 2048, 0, 2048, 2048, nullptr, WS_WO0, 2048, 0, 0, 0)
        JOB(ap->w_ff1, 8192, 0, 8192, 2048, ap->g_mlp_pre, WS_WFF1_0, 2048, 0, 0, 0)
        JOB(ap->w_ff2, 2048, 0, 2048, 8192, nullptr, WS_WFF2_0, LDF, 0, 0, 0)
        JOB(ap->w_mem_k, 512, 0, 512, 2048, ap->g_mem, WS_WMEM0, 2048, 0, 0, 0)
        JOB(ap->w_mem_v, 512, 0, 512, 2048, ap->g_mem, WS_WMEM0, 2048, 0, 0, 512)
        JOB(ap->w_mem_k + 2048 * 512, 512, 0, 512, 2048, ap->g_mem + 2048, WS_WMEM1, 2048, 0, 0, 0)
        JOB(ap->w_mem_v + 2048 * 512, 512, 0, 512, 2048, ap->g_mem + 2048, WS_WMEM1, 2048, 0, 0, 512)
        JOBF(ap->w_o + 2048 * 2048, 2048, 0, 2048, 2048, nullptr, WS_WO1, 2048, 0, 0, 0)
        JOBF(ap->w_ff1 + 2048 * 8192, 8192, 0, 8192, 2048, ap->g_mlp_pre + 2048, WS_WFF1_1, 2048, 0, 0, 0)
        JOBF(ap->b_w_in, 1280, 0, 1280, 2048, ap->g_mix_pre + 2048, WS_WBIN, 2048, 0, 0, 0)
        JOBF(ap->kv_w_down, 576, 0, 512, 2048, ap->kv_g_in, WS_WBIN, 2048, 0, 0, 1280)
        JOBF(ap->kv_w_down, 576, 512, 64, 2048, ap->kv_g_in, WS_WBIN, 2048, 0, 2, 1792)
        JOBF(ap->b_w_qb, 2304, 0, 2304, 768, ap->b_g_qa, WS_WQB, 768, 0, 1, 0)
        JOBF(ap->kv_w_up, 3072, 0, 3072, 512, ap->kv_g_latent, WS_WUP, 512, 0, 0, 0)
        for (int blk = 0; blk < 12; ++blk) {
            JOB(ap->a_w_r + blk * 16384, 128, 0, 128, 128, nullptr, WS_WGATE + (size_t)(blk >> 1) * 512 * 256 * 2, 256, (blk & 1) * 128, 0, (blk & 1) * 256)
            JOB(ap->a_w_i + blk * 16384, 128, 0, 128, 128, nullptr, WS_WGATE + (size_t)(blk >> 1) * 512 * 256 * 2, 256, (blk & 1) * 128, 0, (blk & 1) * 256 + 128)
        }
#undef JOB
#undef JOBF
        __syncthreads();
    }
    cg::this_grid().sync();

    if ((PHMASK >> 1) & 1) { PHASE_BEGIN
        { EpiA1 e{WSP(bf16_t, WS_XBR), WSP(bf16_t, WS_GG), WSP(bf16_t, WS_QMA), WSP(const float, WS_RSTD)};
          RUN_GEMM(EpiA1, e, WSP(const bf16_t, WS_HB), WSP(const bf16_t, WS_WAIN), 2048, 2048, 2048, T, 3584, bx); }
        { EpiStd<0> e{WSP(bf16_t, WS_MEMKV), 1024, WSP(const float, WS_RSTDMEM), 0.f, 1.f};
          RUN_GEMM(EpiStd<0>, e, WSP(const bf16_t, WS_MEMB), WSP(const bf16_t, WS_WMEM0), 2048, 2048, 2048, 1024, 1024, (bx + G - 128 % G) % G); }
        { EpiStd<0> e{WSP(bf16_t, WS_MEMKV + 2 * MiB), 1024, WSP(const float, WS_RSTDMEM), 0.f, 1.f};
          RUN_GEMM(EpiStd<0>, e, WSP(const bf16_t, WS_MEMB), WSP(const bf16_t, WS_WMEM1), 2048, 2048, 2048, 1024, 1024, (bx + G - 144 % G) % G); }
        { const int nidle = G > 160 ? G - 160 : G, first = G > 160 ? 160 : 0;
          if (bx >= first) { LAS float* scr = (LAS float*)(ldsl + wave * 16384); int it = (bx - first) * 8 + wave;
              tr_job(it, nidle * 8, ap->w_ff2 + 2048 * 8192, 2048, 0, 2048, 8192, nullptr, WSP(bf16_t, WS_WFF2_1), LDF, 0, 0, 0, scr, lane, true); } }
    }
    SEAM();

    if ((PHMASK >> 2) & 1) { PHASE_BEGIN
        const bf16_t* xbr = WSP(const bf16_t, WS_XBR); bf16_t* xc = WSP(bf16_t, WS_XC); const float* cw = ap->a_conv_w; const float* cb = ap->a_conv_b;
        for (int task = gt; task < 512 * 192; task += NGT) { const int r = task / 192, c8 = (task - r * 192) * 8, t0 = r * 32;
            f32x4 wl[4], wh[4];
#pragma unroll
            for (int j = 0; j < 4; ++j) { wl[j] = *(const f32x4*)(cw + j * 1536 + c8); wh[j] = *(const f32x4*)(cw + j * 1536 + c8 + 4); }
            const f32x4 bl = *(const f32x4*)(cb + c8), bh = *(const f32x4*)(cb + c8 + 4);
            const bf16_t* xp = xbr + (size_t)t0 * 1536 + c8; bf16_t* op = xc + (size_t)t0 * 1536 + c8;
            u32x4 x0 = {0u, 0u, 0u, 0u}, x1 = x0, x2 = x0;
            if ((t0 & (SEQ - 1)) != 0) { x0 = *(const u32x4*)(xp - 3 * 1536); x1 = *(const u32x4*)(xp - 2 * 1536); x2 = *(const u32x4*)(xp - 1536); }
#define CMAC(al, ah, wlo, whi, xv) do { al[0] += wlo[0] * bflo(xv.x); al[1] += wlo[1] * bfhi(xv.x); al[2] += wlo[2] * bflo(xv.y); al[3] += wlo[3] * bfhi(xv.y); \
                ah[0] += whi[0] * bflo(xv.z); ah[1] += whi[1] * bfhi(xv.z); ah[2] += whi[2] * bflo(xv.w); ah[3] += whi[3] * bfhi(xv.w); } while (0)
#pragma unroll 8
            for (int s = 0; s < 32; ++s) { const u32x4 x3 = *(const u32x4*)(xp + (size_t)s * 1536);
                f32x4 a0 = bl, a1 = bh;
                CMAC(a0, a1, wl[0], wh[0], x0); CMAC(a0, a1, wl[1], wh[1], x1); CMAC(a0, a1, wl[2], wh[2], x2); CMAC(a0, a1, wl[3], wh[3], x3);
                u32x4 o; o.x = cvt_pk_bf16(a0[0], a0[1]); o.y = cvt_pk_bf16(a0[2], a0[3]); o.z = cvt_pk_bf16(a1[0], a1[1]); o.w = cvt_pk_bf16(a1[2], a1[3]);
                *(u32x4*)(op + (size_t)s * 1536) = o; x0 = x1; x1 = x2; x2 = x3; }
#undef CMAC
        }
        __syncthreads();
        for (int u = bx; u < 256; u += G) { const int qb = u & 15, h = (u >> 4) & 3, b = u >> 6;
            const bf16_t* mkv = WSP(const bf16_t, WS_MEMKV) + (size_t)(b * 256) * 1024 + h * 128;
            AttnArgs a{WSP(const bf16_t, WS_QMA) + (size_t)(b * SEQ + qb * 256) * 512 + h * 128, 512, mkv, 1024, nullptr, mkv + 512, 1024,
                       WSP(bf16_t, WS_CC) + (size_t)(b * SEQ + qb * 256) * DM + 1536 + h * 128, DM, 4, 1 << 20};
            attn_unit<8>(a, (char*)lds); }
    }
    SEAM();

    if ((PHMASK >> 3) & 1) { PHASE_BEGIN
        EpiGate e{WSP(const bf16_t, WS_XC), ap->a_b_r, ap->a_b_i, WSP(unsigned, WS_RU)};
        pg8::Gemm g_{WSP(const bf16_t, WS_XC), WSP(const bf16_t, WS_WGATE), 1536, 256, 256, 512, (size_t)512 * 256 * 2};
        SO S_; S_.init(T, 3072, G, bx, 2);
        pg8::gemm_phase<EpiGate, SO, true, true>(ldsl, g_, S_, e);
    }
    SEAM();

    if ((PHMASK >> 4) & 1) { PHASE_BEGIN
        const unsigned* RU = WSP(const unsigned, WS_RU); float2* agg = WSP(float2, WS_AGG); const float* lam = ap->a_lambda;
        for (int u = bx; u < 768; u += G) { const int slab = u % 3, k = (u / 3) & 63, b = u / 192, ch = slab * 512 + tid;
            const float c2 = -8.f * 1.4426950408889634f * log1pf(__expf(-lam[ch]));
            const unsigned* p = RU + (size_t)(b * SEQ + k * 64) * 1536 + ch; float Aa = 1.f, Bb = 0.f;
#pragma unroll 16
            for (int i = 0; i < 64; ++i) { const unsigned w = p[(size_t)i * 1536]; const float a = __builtin_amdgcn_exp2f(bflo(w) * c2);
                const float bb = sqrtf(fmaxf(1.f - a * a, 0.f)) * bfhi(w); Bb = a * Bb + bb; Aa *= a; }
            agg[(size_t)(b * 64 + k) * 1536 + ch] = make_float2(Aa, Bb); }
    }
    SEAM();

    if ((PHMASK >> 5) & 1) { PHASE_BEGIN
        const unsigned* RU = WSP(const unsigned, WS_RU); const float2* agg = WSP(const float2, WS_AGG); const bf16_t* gg = WSP(const bf16_t, WS_GG); const float* lam = ap->a_lambda;
        for (int u = bx; u < 768; u += G) { const int slab = u % 3, k = (u / 3) & 63, b = u / 192, ch = slab * 512 + tid;
            const float c2 = -8.f * 1.4426950408889634f * log1pf(__expf(-lam[ch]));
            float h = 0.f;
            for (int kk = 0; kk < k; kk += 8) { float2 ab[8];
#pragma unroll
                for (int j = 0; j < 8; ++j) ab[j] = (kk + j < k) ? agg[(size_t)(b * 64 + kk + j) * 1536 + ch] : make_float2(1.f, 0.f);
#pragma unroll
                for (int j = 0; j < 8; ++j) h = ab[j].x * h + ab[j].y; }
            const size_t r0 = (size_t)(b * SEQ + k * 64);
            const unsigned* p = RU + r0 * 1536 + ch; const bf16_t* gp = gg + r0 * 1536 + ch; bf16_t* op = WSP(bf16_t, WS_CC) + r0 * DM + ch;
#pragma unroll 16
            for (int i = 0; i < 64; ++i) { const unsigned w = p[(size_t)i * 1536]; const float a = __builtin_amdgcn_exp2f(bflo(w) * c2);
                const float bb = sqrtf(fmaxf(1.f - a * a, 0.f)) * bfhi(w); h = a * h + bb;
                const float gv = __uint_as_float((unsigned)gp[(size_t)i * 1536] << 16);
                op[(size_t)i * DM] = (bf16_t)(cvt_pk_bf16(h * gv, 0.f) & 0xffffu); } }
    }
    SEAM();

#pragma unroll
    for (int layer = 0; layer < 2; ++layer) {
        if (layer == 1) {
            if ((PHMASK >> 6) & 1) { PHASE_BEGIN
                EpiB1 e{WSP(bf16_t, WS_CQ), WSP(bf16_t, WS_QMB), WSP(bf16_t, WS_CKV), WSP(bf16_t, WS_KPE), WSP(float, WS_SSQCQ), WSP(float, WS_SSQLAT), WSP(const float, WS_SSQH) + T, WSP(const float, WS_COS), WSP(const float, WS_SIN)};
                RUN_GEMM(EpiB1, e, WSP(const bf16_t, WS_HB), WSP(const bf16_t, WS_WBIN), 2048, 2048, 2048, T, 2048, bx);
            }
            SEAM();
            if ((PHMASK >> 7) & 1) { PHASE_BEGIN
                { EpiStd<0> e{WSP(bf16_t, WS_KV), 3072, WSP(const float, WS_SSQLAT), 1.f / 512.f, 1.f};
                  RUN_GEMM(EpiStd<0>, e, WSP(const bf16_t, WS_CKV), WSP(const bf16_t, WS_WUP), 512, 512, 512, T, 3072, bx); }
                { EpiQ e{WSP(bf16_t, WS_Q), WSP(const float, WS_SSQCQ), WSP(const float, WS_COS), WSP(const float, WS_SIN)};
                  RUN_GEMM(EpiQ, e, WSP(const bf16_t, WS_CQ), WSP(const bf16_t, WS_WQB), 768, 768, 768, T, 2304, bx); }
            }
            SEAM();
            if ((PHMASK >> 8) & 1) { PHASE_BEGIN
                for (int slot = 0; slot < (G == 256 ? ATT_SLOTS : 1024 / G + 1); ++slot) {
                    int code;
                    if (G == 256) code = g_att_sched[bx][slot]; else { const int p = slot * G + bx; code = p < 1024 ? (p < 768 ? p : 1024 + (p - 768)) : 0xFFFF; }
                    if (code == 0xFFFF) continue;
                    if (code < 1024) { const int qb = code & 15, bh = code >> 4, b = bh / 12, h = bh - b * 12;
                        const bf16_t* kv = WSP(const bf16_t, WS_KV) + (size_t)(b * SEQ) * 3072 + h * 256;
                        AttnArgs a{WSP(const bf16_t, WS_Q) + (size_t)(b * SEQ + qb * 256) * 2304 + h * 192, 2304, kv, 3072, WSP(const bf16_t, WS_KPE) + (size_t)(b * SEQ) * 64,
                                   kv + 128, 3072, WSP(bf16_t, WS_CC) + (size_t)(b * SEQ + qb * 256) * DM + h * 128, DM, 4 * qb + 4, 4 * qb};
                        attn_unit<12>(a, (char*)lds); }
                    else { const int u = code - 1024, qb = u & 15, h = (u >> 4) & 3, b = u >> 6;
                        const bf16_t* mkv = WSP(const bf16_t, WS_MEMKV + 2 * MiB) + (size_t)(b * 256) * 1024 + h * 128;
                        AttnArgs a{WSP(const bf16_t, WS_QMB) + (size_t)(b * SEQ + qb * 256) * 512 + h * 128, 512, mkv, 1024, nullptr, mkv + 512, 1024,
                                   WSP(bf16_t, WS_CC) + (size_t)(b * SEQ + qb * 256) * DM + 1536 + h * 128, DM, 4, 1 << 20};
                        attn_unit<8>(a, (char*)lds); }
                }
            }
            SEAM();
        }
        const size_t wo_off = layer ? WS_WO1 : WS_WO0, wf1_off = layer ? WS_WFF1_1 : WS_WFF1_0, wf2_off = layer ? WS_WFF2_1 : WS_WFF2_0;
#pragma unroll
        for (int hf = 0; hf < 2; ++hf) {
            if ((PHMASK >> 10) & 1) { PHASE_BEGIN
                LAS float* Pl = (LAS float*)(ldsl + 131072 + 1024);
                if (layer == 0) { EpiNorm<true, false> e{ap->x, WSP(bf16_t, WS_HB), nullptr, ap->g_mix_post, WSP(float, WS_SSQY), WSP(float, WS_SSQH), WSP(unsigned, WS_CNT), hf * 8192, Pl};
                    RUN_GEMM(EN_TF, e, WSP(const bf16_t, WS_CC) + (size_t)hf * 8192 * DM, (const bf16_t*)(ws + wo_off), 2048, 2048, 2048, 8192, 2048, bx); }
                else { EpiNorm<false, false> e{nullptr, WSP(bf16_t, WS_HB), nullptr, ap->g_mix_post + DM, WSP(float, WS_SSQY) + 2 * T, WSP(float, WS_SSQH) + 2 * T, WSP(unsigned, WS_CNT) + 2 * 64 * 64, hf * 8192, Pl};
                    RUN_GEMM(EN_FF, e, WSP(const bf16_t, WS_CC) + (size_t)hf * 8192 * DM, (const bf16_t*)(ws + wo_off), 2048, 2048, 2048, 8192, 2048, bx); }
            }
            if (hf == 1) SEAM();
        }
#pragma unroll
        for (int hf = 0; hf < 2; ++hf) {
            if ((PHMASK >> 12) & 1) { PHASE_BEGIN EpiStd<2> e{WSP(bf16_t, WS_F), LDF, WSP(const float, WS_SSQH) + (layer * 2) * T + hf * 8192, 1.f / DM, 1.f};
                RUN_GEMM(EpiStd<2>, e, WSP(const bf16_t, WS_HB) + (size_t)hf * 8192 * DM, (const bf16_t*)(ws + wf1_off), 2048, 2048, 2048, 8192, 8192, bx); }
            SEAM();
            if ((PHMASK >> 13) & 1) { PHASE_BEGIN
                LAS float* Pl = (LAS float*)(ldsl + 131072 + 1024);
                if (layer == 0) { EpiNorm<false, false> e{nullptr, WSP(bf16_t, WS_HB), nullptr, ap->g_mlp_post, WSP(float, WS_SSQY) + T, WSP(float, WS_SSQH) + T, WSP(unsigned, WS_CNT) + 64 * 64, hf * 8192, Pl};
                    RUN_GEMM(EN_FF, e, WSP(const bf16_t, WS_F), (const bf16_t*)(ws + wf2_off), LDF, LDF, 8192, 8192, 2048, bx); }
                else { EpiNorm<false, true> e{nullptr, WSP(bf16_t, WS_HB), ap->out, ap->g_mlp_post + DM, WSP(float, WS_SSQY) + 3 * T, WSP(float, WS_SSQH) + 3 * T, WSP(unsigned, WS_CNT) + 3 * 64 * 64, hf * 8192, Pl};
                    RUN_GEMM(EN_FT, e, WSP(const bf16_t, WS_F), (const bf16_t*)(ws + wf2_off), LDF, LDF, 8192, 8192, 2048, bx); }
            }
            if (!(layer == 1 && hf == 1)) SEAM();
        }
    }
#undef SEAM
}

extern "C" void kernel_launch(void* const* d_in, const int* in_sizes, int n_in, void* d_out, int out_size, void* d_ws, size_t ws_size, hipStream_t stream) {
    static int grid = 0;
    if (grid == 0) {
        if (n_in != 28 || in_sizes[0] != T * DM || out_size != T * DM || ws_size < WS_END) {
            fprintf(stderr, "kernel_launch: unexpected shapes: n_in %d in0 %d out %d ws %zu (need %zu)\n", n_in, n_in > 0 ? in_sizes[0] : -1, out_size, ws_size, (size_t)WS_END); grid = -1; return; }
        int dev = 0, cus = 0, per_cu = 0;
        (void)hipGetDevice(&dev); (void)hipDeviceGetAttribute(&cus, hipDeviceAttributeMultiprocessorCount, dev);
        if (hipFuncSetAttribute((const void*)fwd_mega, hipFuncAttributeMaxDynamicSharedMemorySize, LDS_BYTES) != hipSuccess) fprintf(stderr, "kernel_launch: hipFuncSetAttribute failed\n");
        if (hipOccupancyMaxActiveBlocksPerMultiprocessor(&per_cu, (const void*)fwd_mega, 512, LDS_BYTES) != hipSuccess || per_cu < 1) { fprintf(stderr, "kernel_launch: occupancy query says %d\n", per_cu); per_cu = 1; }
        (void)hipGetLastError();
        grid = cus * 1;
        if (grid <= 0) grid = 256;
    }
    if (grid < 0) return;
    Args a{};
    a.x = (const float*)d_in[0]; a.mem = (const float*)d_in[1]; a.pos = (const int*)d_in[2];
    a.g_mix_pre = (const float*)d_in[3]; a.g_mix_post = (const float*)d_in[4]; a.g_mlp_pre = (const float*)d_in[5]; a.g_mlp_post = (const float*)d_in[6]; a.g_mem = (const float*)d_in[7];
    a.w_mem_k = (const float*)d_in[8]; a.w_mem_v = (const float*)d_in[9]; a.w_o = (const float*)d_in[10]; a.w_ff1 = (const float*)d_in[11]; a.w_ff2 = (const float*)d_in[12];
    a.a_w_in = (const float*)d_in[13]; a.a_conv_w = (const float*)d_in[14]; a.a_conv_b = (const float*)d_in[15]; a.a_w_r = (const float*)d_in[16]; a.a_b_r = (const float*)d_in[17];
    a.a_w_i = (const float*)d_in[18]; a.a_b_i = (const float*)d_in[19]; a.a_lambda = (const float*)d_in[20];
    a.b_w_in = (const float*)d_in[21]; a.b_g_qa = (const float*)d_in[22]; a.b_w_qb = (const float*)d_in[23];
    a.kv_g_in = (const float*)d_in[24]; a.kv_w_down = (const float*)d_in[25]; a.kv_g_latent = (const float*)d_in[26]; a.kv_w_up = (const float*)d_in[27 + 0];
    a.out = (float*)d_out; a.ws = (unsigned char*)d_ws;
    for (int i = 0; i < 32; ++i) a.invf[i] = (float)pow(10000.0, -(double)i / 32.0);
    a.ph_lo = 0; a.ph_hi = 1000;
    (void)hipMemsetAsync((unsigned char*)d_ws + WS_BAR, 0, 16384, stream);
    void* kargs[] = {&a};
    hipError_t e = hipLaunchCooperativeKernel((const void*)fwd_mega, dim3(grid), dim3(512), kargs, LDS_BYTES, stream);
    if (e != hipSuccess) fprintf(stderr, "kernel_launch: cooperative launch failed: %s (grid %d)\n", hipGetErrorString(e), grid);
}
```

```cpp
#include <hip/hip_runtime.h>
#include <hip/hip_cooperative_groups.h>
#include <cstdio>
#include <cstdint>
#include <cmath>
namespace cg = cooperative_groups;

#define LAS __attribute__((address_space(3)))
typedef unsigned short bf16_t;
typedef short bf16x8 __attribute__((ext_vector_type(8)));
typedef short s16x4 __attribute__((ext_vector_type(4)));
typedef float f32x4 __attribute__((ext_vector_type(4)));
typedef float f32x16 __attribute__((ext_vector_type(16)));
typedef unsigned u32x4 __attribute__((ext_vector_type(4)));
typedef unsigned u32x2 __attribute__((ext_vector_type(2)));

constexpr int T = 16384, DM = 2048, SEQ = 4096, NBATCH = 4;
constexpr float EPS = 1e-6f;
constexpr float MEMSCALE = 0.08838834764831845f * 1.4426950408889634f;
constexpr float QSCALE = 0.07216878364870322f * 1.4426950408889634f;
constexpr size_t MiB = 1u << 20;
constexpr size_t WS_RSTD = 0, WS_SSQCQ = 65536, WS_SSQLAT = 131072, WS_RSTDMEM = 196608;
constexpr size_t WS_BAR = 262144;
constexpr size_t WS_SSQY = 320 * 1024, WS_SSQH = 576 * 1024, WS_CNT = 832 * 1024, WS_CTL_ZERO_END = 896 * 1024;
constexpr size_t WS_MEMKV = 1 * MiB;
constexpr size_t WS_COS = 5 * MiB, WS_SIN = 7 * MiB;
constexpr int LDF = 8192 + 64;
constexpr size_t KiB = 1024;
constexpr size_t WS_WAIN = 9 * MiB, WS_WO0 = 23 * MiB, WS_WFF1_0 = 31 * MiB, WS_WFF2_0 = 63 * MiB, WS_WGATE = 95 * MiB + 256 * KiB, WS_WMEM0 = 96 * MiB + 768 * KiB, WS_WMEM1 = 100 * MiB + 768 * KiB,
                 WS_WO1 = 104 * MiB + 768 * KiB, WS_WFF1_1 = 112 * MiB + 768 * KiB, WS_WFF2_1 = 144 * MiB + 768 * KiB, WS_WBIN = 177 * MiB, WS_WQB = 185 * MiB, WS_WUP = 188 * MiB + 384 * KiB;
static_assert(WS_WFF2_0 + (size_t)2048 * LDF * 2 <= WS_WGATE && WS_WFF2_1 + (size_t)2048 * LDF * 2 <= WS_WBIN && WS_WUP + 3 * MiB <= 192 * MiB, "weight map");
constexpr size_t WS_HB = 192 * MiB, WS_Y = 256 * MiB, WS_CC = 320 * MiB, WS_ARENA = 384 * MiB, WS_END = 512 * MiB;
constexpr size_t WS_GG = WS_Y;
constexpr size_t WS_MEMB = WS_Y + 48 * MiB;
constexpr size_t WS_XBR = WS_ARENA, WS_QMA = WS_ARENA + 48 * MiB;
constexpr size_t WS_XC = WS_HB;
constexpr size_t WS_RU = WS_ARENA;
constexpr size_t WS_AGG = WS_ARENA + 96 * MiB;
constexpr size_t WS_F = WS_ARENA - 1 * MiB;
constexpr size_t WS_CQ = WS_Y, WS_QMB = WS_Y + 24 * MiB, WS_CKV = WS_Y + 40 * MiB, WS_KPE = WS_Y + 56 * MiB;
constexpr size_t WS_Q = WS_WAIN;
constexpr size_t WS_KV = WS_ARENA;
static_assert(WS_F + (size_t)8192 * LDF * 2 <= WS_END && WS_Q + 72 * MiB <= WS_WMEM1 + 4 * MiB, "map");

namespace pg8 {
constexpr int BM = 256, BK = 64, HALF = 128, HTB = HALF * BK * 2, STAGE_BYTES = 8 * HTB, NXCD = 8, WGM = 8;
__host__ __device__ __forceinline__ int lds_byte(int r, int c) { const int st = (r >> 4) * 2 + (c >> 5), rr = r & 15, cc = c & 31, ob = rr * 64 + cc * 2; return st * 1024 + (ob ^ (((ob >> 9) & 1) << 5)); }
__host__ __device__ __forceinline__ void stage_rc(int b, int& R, int& C) { const int st = b / 1024, sb = b % 1024, swz = sb ^ (((sb >> 9) & 1) << 5); R = (st >> 1) * 16 + swz / 64; C = (st & 1) * 32 + (swz % 64) / 2; }
__host__ __device__ __forceinline__ int perm32(int rho) { const int n = rho >> 4, i = rho & 15; return 8 * (i >> 2) + 4 * n + (i & 3); }

struct Unit { int pm, pn, g; };
struct Gemm { const bf16_t* A; const bf16_t* Bt; int lda, ldb, K; size_t gsA, gsB; };

struct StaticOrder {
    int nM, nN, nwg, G, c, gdiv;
    __device__ void init(int M, int N, int G_, int c_, int gdiv_ = 1 << 20) { nM = M / BM; nN = N / BM; nwg = nM * nN; G = G_; c = c_; gdiv = gdiv_; }
    __device__ bool next(int i, Unit& u) const {
        const long L = (long)i * G + c; if (L >= nwg) return false;
        int wgid = (int)L; { const int q = nwg / NXCD, r = nwg % NXCD, xcd = wgid % NXCD, off = wgid / NXCD; wgid = (xcd < r ? xcd * (q + 1) : r * (q + 1) + (xcd - r) * q) + off; }
        const int nig = WGM * nN, gid = wgid / nig, fm = gid * WGM, gsz = (nM - fm) < WGM ? (nM - fm) : WGM;
        u.pm = fm + ((wgid % nig) % gsz); const int pnv = (wgid % nig) / gsz; u.g = pnv / gdiv; u.pn = pnv - u.g * gdiv; return true;
    }
    __device__ __forceinline__ void a_ready(const Unit&) const {}
    __device__ __forceinline__ void done(const Unit&) const {}
};

__device__ __forceinline__ unsigned cvt_pk_bf16(float lo, float hi) { unsigned r; asm volatile("v_cvt_pk_bf16_f32 %0, %1, %2" : "=v"(r) : "v"(lo), "v"(hi)); return r; }

template <class Epi, class Sched, bool ALIGN_EPI = false, bool SP2 = false>
__device__ __forceinline__ void gemm_phase(LAS unsigned char* lds, const Gemm g, const Sched& S, const Epi& E) {
    int tid_ = threadIdx.x; asm volatile("" : "+v"(tid_));
    const int tid = tid_, wid = __builtin_amdgcn_readfirstlane(tid >> 6), lane = tid & 63, wr = wid >> 2, wc = wid & 3, fr = lane & 15, fq = lane >> 4;
    const int K = g.K, nt = K / BK;
    unsigned voffA[2], voffB[2];
#pragma unroll
    for (int i = 0; i < 2; ++i) { int R, C; stage_rc(tid * 16 + i * 8192, R, C); const int Rb = Epi::PERM ? ((R & ~31) + perm32(R & 31)) : R;
        voffA[i] = (unsigned)(R * g.lda + C) * 2u; voffB[i] = (unsigned)(Rb * g.ldb + C) * 2u; }
    const size_t kstep = (size_t)(BK * 2);
    const size_t hstepA = (size_t)HALF * g.lda * 2, hstepB = (size_t)HALF * g.ldb * 2;
    const size_t tstepA = 2 * hstepA, tstepB = 2 * hstepB;
    const unsigned ldsw = (unsigned)wid * 1024u;
    const int aoff = lds_byte(wr * 64 + fr, fq * 8), boff = lds_byte(wc * 32 + fr, fq * 8);
#define PG8_SA(b, h) (((b) * 2 + (h)) * HTB)
#define PG8_SB(b, h) ((4 + (b) * 2 + (h)) * HTB)
#define PG8_STAGE(bufoff, gbase, voff) do { _Pragma("unroll") for (int _i = 0; _i < 2; ++_i) \
        __builtin_amdgcn_global_load_lds((const unsigned*)((const char*)(gbase) + (voff)[_i]), (LAS unsigned*)(lds + (bufoff) + ldsw + _i * 8192), 16, 0, 0); } while (0)
#define PG8_LDA(dst, b, h) do { _Pragma("unroll") for (int m = 0; m < 4; ++m) _Pragma("unroll") for (int k = 0; k < 2; ++k) dst[m][k] = *(const LAS bf16x8*)(lds + PG8_SA(b, h) + aoff + m * 2048 + k * 1024); } while (0)
#define PG8_LDB(dst, b, h) do { _Pragma("unroll") for (int n = 0; n < 2; ++n) _Pragma("unroll") for (int k = 0; k < 2; ++k) dst[n][k] = *(const LAS bf16x8*)(lds + PG8_SB(b, h) + boff + n * 2048 + k * 1024); } while (0)
#define PG8_MMA(ai, bj, At, Bt) do { __builtin_amdgcn_s_setprio(1); _Pragma("unroll") for (int m = 0; m < 4; ++m) _Pragma("unroll") for (int n = 0; n < 2; ++n) _Pragma("unroll") for (int k = 0; k < 2; ++k) \
        acc[ai][bj][m][n] = __builtin_amdgcn_mfma_f32_16x16x32_bf16(Bt[n][k], At[m][k], acc[ai][bj][m][n], 0, 0, 0); __builtin_amdgcn_s_setprio(0); } while (0)
#define PG8_WAIT_V(n) asm volatile("s_waitcnt vmcnt(" #n ")" ::: "memory")
#define PG8_WAIT_L(n) asm volatile("s_waitcnt lgkmcnt(" #n ")" ::: "memory")
#define PG8_BAR __builtin_amdgcn_s_barrier()
#define PG8_SCHED __builtin_amdgcn_sched_barrier(0)
    Unit cur, nxt; int ui = 0;
    if (!S.next(0, cur)) return;
    f32x4 acc[2][2][4][2];
#pragma unroll
    for (int a = 0; a < 2; ++a)
#pragma unroll
        for (int b = 0; b < 2; ++b)
#pragma unroll
            for (int m = 0; m < 4; ++m)
#pragma unroll
                for (int n = 0; n < 2; ++n) acc[a][b][m][n] = (f32x4){0.f, 0.f, 0.f, 0.f};
    bf16x8 At[4][2], B0[2][2], B1[2][2];
    const char* cA = (const char*)g.A + (size_t)cur.g * g.gsA + (size_t)cur.pm * tstepA; const char* cB = (const char*)g.Bt + (size_t)cur.g * g.gsB + (size_t)cur.pn * tstepB;
    S.a_ready(cur);
    if constexpr (SP2) {
        PG8_STAGE(PG8_SB(0, 0), cB, voffB); PG8_STAGE(PG8_SB(0, 1), cB + hstepB, voffB); PG8_STAGE(PG8_SA(0, 0), cA, voffA); PG8_STAGE(PG8_SA(0, 1), cA + hstepA, voffA);
        if (wr == 1) PG8_BAR;
        PG8_WAIT_V(2); PG8_BAR;
        PG8_STAGE(PG8_SB(1, 0), cB + kstep, voffB); PG8_STAGE(PG8_SA(1, 0), cA + kstep, voffA); PG8_STAGE(PG8_SB(1, 1), cB + hstepB + kstep, voffB);
        PG8_WAIT_V(6); PG8_BAR;
    } else {
        PG8_STAGE(PG8_SB(0, 0), cB, voffB); PG8_STAGE(PG8_SA(0, 0), cA, voffA); PG8_STAGE(PG8_SB(0, 1), cB + hstepB, voffB); PG8_STAGE(PG8_SA(0, 1), cA + hstepA, voffA);
        if (wr == 1) PG8_BAR;
        PG8_WAIT_V(4); PG8_BAR;
        PG8_STAGE(PG8_SB(1, 0), cB + kstep, voffB); PG8_STAGE(PG8_SA(1, 0), cA + kstep, voffA); PG8_STAGE(PG8_SB(1, 1), cB + hstepB + kstep, voffB);
        PG8_WAIT_V(6); PG8_BAR;
    }
    for (;;) {
        const bool has_next = S.next(ui + 1, nxt);
        const char* nA = has_next ? (const char*)g.A + (size_t)nxt.g * g.gsA + (size_t)nxt.pm * tstepA : cA; const char* nB = has_next ? (const char*)g.Bt + (size_t)nxt.g * g.gsB + (size_t)nxt.pn * tstepB : cB;
        for (int t = 0; t < nt; t += 2) {
            const bool last = (t == nt - 2);
            const char* a1 = cA + (size_t)(t + 1) * kstep;
            const char* a2 = last ? nA : cA + (size_t)(t + 2) * kstep; const char* b2 = last ? nB : cB + (size_t)(t + 2) * kstep;
            const char* a3 = a2 + kstep; const char* b3 = b2 + kstep;
            if (last && has_next) S.a_ready(nxt);
            if constexpr (SP2) {
            PG8_LDB(B0, 0, 0); PG8_LDB(B1, 0, 1); PG8_SCHED; PG8_LDA(At, 0, 0); PG8_STAGE(PG8_SA(1, 1), a1 + hstepA, voffA);
            PG8_WAIT_V(8); PG8_WAIT_L(0); PG8_BAR; PG8_MMA(0, 0, At, B0); PG8_MMA(0, 1, At, B1); PG8_BAR; PG8_SCHED;
            PG8_LDA(At, 0, 1); PG8_STAGE(PG8_SB(0, 0), b2, voffB); PG8_STAGE(PG8_SB(0, 1), b2 + hstepB, voffB); PG8_STAGE(PG8_SA(0, 0), a2, voffA);
            PG8_WAIT_V(8); PG8_WAIT_L(0); PG8_BAR; PG8_MMA(1, 0, At, B0); PG8_MMA(1, 1, At, B1); PG8_BAR; PG8_SCHED;
            PG8_LDB(B0, 1, 0); PG8_LDB(B1, 1, 1); PG8_SCHED; PG8_LDA(At, 1, 0); PG8_STAGE(PG8_SA(0, 1), a2 + hstepA, voffA);
            PG8_WAIT_V(8); PG8_WAIT_L(0); PG8_BAR; PG8_MMA(0, 0, At, B0); PG8_MMA(0, 1, At, B1); PG8_BAR; PG8_SCHED;
            PG8_LDA(At, 1, 1); PG8_STAGE(PG8_SB(1, 0), b3, voffB); PG8_STAGE(PG8_SB(1, 1), b3 + hstepB, voffB); PG8_STAGE(PG8_SA(1, 0), a3, voffA);
            PG8_WAIT_V(8); PG8_WAIT_L(0); PG8_BAR; PG8_MMA(1, 0, At, B0); PG8_MMA(1, 1, At, B1); PG8_BAR; PG8_SCHED;
            } else {
            PG8_LDB(B0, 0, 0); PG8_SCHED; PG8_LDA(At, 0, 0); PG8_STAGE(PG8_SA(1, 1), a1 + hstepA, voffA);
            PG8_WAIT_L(8); PG8_BAR; PG8_WAIT_L(0); PG8_MMA(0, 0, At, B0); PG8_BAR; PG8_SCHED;
            PG8_LDB(B1, 0, 1); PG8_STAGE(PG8_SB(0, 0), b2, voffB);
            PG8_BAR; PG8_WAIT_L(0); PG8_MMA(0, 1, At, B1); PG8_BAR;
            PG8_LDA(At, 0, 1); PG8_STAGE(PG8_SA(0, 0), a2, voffA);
            PG8_BAR; PG8_WAIT_L(0); PG8_MMA(1, 0, At, B0); PG8_BAR; PG8_SCHED;
            PG8_STAGE(PG8_SB(0, 1), b2 + hstepB, voffB);
            PG8_WAIT_V(6); PG8_BAR; PG8_MMA(1, 1, At, B1); PG8_BAR;
            PG8_LDB(B0, 1, 0); PG8_SCHED; PG8_LDA(At, 1, 0); PG8_STAGE(PG8_SA(0, 1), a2 + hstepA, voffA);
            PG8_WAIT_L(8); PG8_BAR; PG8_WAIT_L(0); PG8_MMA(0, 0, At, B0); PG8_BAR; PG8_SCHED;
            PG8_LDB(B1, 1, 1); PG8_STAGE(PG8_SB(1, 0), b3, voffB);
            PG8_BAR; PG8_WAIT_L(0); PG8_MMA(0, 1, At, B1); PG8_BAR;
            PG8_LDA(At, 1, 1); PG8_STAGE(PG8_SA(1, 0), a3, voffA);
            PG8_BAR; PG8_WAIT_L(0); PG8_MMA(1, 0, At, B0); PG8_BAR; PG8_SCHED;
            PG8_STAGE(PG8_SB(1, 1), b3 + hstepB, voffB);
            PG8_WAIT_V(6); PG8_BAR; PG8_MMA(1, 1, At, B1); PG8_BAR;
            }
        }
        if constexpr (ALIGN_EPI) { if (wr == 0) PG8_BAR; }
        { int fr2 = fr, fq2 = fq; asm volatile("" : "+v"(fr2), "+v"(fq2)); E(acc, cur, wr, wc, fr2, fq2); } S.done(cur);
        if (!has_next) break;
#pragma unroll
        for (int a = 0; a < 2; ++a)
#pragma unroll
            for (int b = 0; b < 2; ++b)
#pragma unroll
                for (int m = 0; m < 4; ++m)
#pragma unroll
                    for (int n = 0; n < 2; ++n) acc[a][b][m][n] = (f32x4){0.f, 0.f, 0.f, 0.f};
        cur = nxt; cA = nA; cB = nB; ++ui;
        if constexpr (ALIGN_EPI) { if (wr == 1) PG8_BAR; }
    }
    PG8_WAIT_V(0);
    if constexpr (!ALIGN_EPI) { if (wr == 0) PG8_BAR; }
    PG8_BAR;
#undef PG8_SA
#undef PG8_SB
#undef PG8_STAGE
#undef PG8_LDA
#undef PG8_LDB
#undef PG8_MMA
#undef PG8_WAIT_V
#undef PG8_WAIT_L
#undef PG8_BAR
#undef PG8_SCHED
}
}
using pg8::cvt_pk_bf16;
using pg8::HALF;

__device__ __forceinline__ float bflo(unsigned w) { return __uint_as_float(w << 16); }
__device__ __forceinline__ float bfhi(unsigned w) { return __uint_as_float(w & 0xffff0000u); }
__device__ __forceinline__ float wave_sum(float v) {
#pragma unroll
    for (int o = 1; o < 64; o <<= 1) v += __shfl_xor(v, o);
    return v;
}
__device__ __forceinline__ float fast_sigmoid(float x) { return __builtin_amdgcn_rcpf(1.f + __builtin_amdgcn_exp2f(-1.4426950408889634f * x)); }
__device__ __forceinline__ float gelu_tanh(float v) { const float u = v + 0.044715f * v * v * v; return v * __builtin_amdgcn_rcpf(1.f + __builtin_amdgcn_exp2f(-2.302208198f * u)); }

template <int ACT>
__device__ __forceinline__ void store_perm(const f32x4 (&acc)[2][2][4][2], bf16_t* O, int ldc, int orow, int ocol, const float* rs, float inv_n, int grow, float cs) {
#pragma unroll
    for (int ai = 0; ai < 2; ++ai)
#pragma unroll
        for (int m = 0; m < 4; ++m) {
            const int ro = ai * HALF + m * 16;
            float s = cs;
            if (rs) { const float q = rs[grow + ro]; s *= (inv_n > 0.f) ? rsqrtf(q * inv_n + EPS) : q; }
            bf16_t* rowp = O + (size_t)(orow + ro) * ldc + ocol;
#pragma unroll
            for (int bj = 0; bj < 2; ++bj) {
                f32x4 v0 = acc[ai][bj][m][0] * s, v1 = acc[ai][bj][m][1] * s;
                if (ACT == 1) {
#pragma unroll
                    for (int j = 0; j < 4; ++j) { v0[j] = gelu_tanh(v0[j]); v1[j] = gelu_tanh(v1[j]); } }
                if (ACT == 2) {
#pragma unroll
                    for (int j = 0; j < 4; ++j) { const float a = fmaxf(v0[j], 0.f), b = fmaxf(v1[j], 0.f); v0[j] = a * a; v1[j] = b * b; } }
                u32x4 w; w.x = cvt_pk_bf16(v0[0], v0[1]); w.y = cvt_pk_bf16(v0[2], v0[3]); w.z = cvt_pk_bf16(v1[0], v1[1]); w.w = cvt_pk_bf16(v1[2], v1[3]);
                *(u32x4*)(rowp + bj * HALF) = w;
            }
        }
}
template <int ACT> struct EpiStd {
    static constexpr bool PERM = true;
    bf16_t* O; int ldc; const float* rs; float inv_n; float cs;
    __device__ __forceinline__ void operator()(const f32x4 (&acc)[2][2][4][2], const pg8::Unit& u, int wr, int wc, int fr, int fq) const {
        const int grow = u.pm * 256 + wr * 64 + fr;
        store_perm<ACT>(acc, O, ldc, grow, u.pn * 256 + wc * 32 + 8 * fq, rs, inv_n, grow, cs);
    }
};
struct EpiA1 {
    static constexpr bool PERM = true;
    bf16_t *xbr, *gg, *qm; const float* rs;
    __device__ __forceinline__ void operator()(const f32x4 (&acc)[2][2][4][2], const pg8::Unit& u, int wr, int wc, int fr, int fq) const {
        const int grow = u.pm * 256 + wr * 64 + fr, cl = wc * 32 + 8 * fq;
        if (u.pn < 6) store_perm<0>(acc, xbr, 1536, grow, u.pn * 256 + cl, rs, 0.f, grow, 1.f);
        else if (u.pn < 12) store_perm<1>(acc, gg, 1536, grow, (u.pn - 6) * 256 + cl, rs, 0.f, grow, 1.f);
        else store_perm<0>(acc, qm, 512, grow, (u.pn - 12) * 256 + cl, rs, 0.f, grow, MEMSCALE);
    }
};
struct EpiGate {
    static constexpr bool PERM = false;
    const bf16_t* xc; const float *br, *bi; unsigned* RU;
    __device__ __forceinline__ void operator()(const f32x4 (&acc)[2][2][4][2], const pg8::Unit& u, int wr, int wc, int fr, int fq) const {
        const int blk = 2 * u.g + u.pn, row0 = u.pm * 256 + wr * 64 + fr, chb = blk * 128 + wc * 32 + 4 * fq;
#pragma unroll
        for (int ai = 0; ai < 2; ++ai)
#pragma unroll
            for (int m = 0; m < 4; ++m) {
#pragma unroll
                for (int n = 0; n < 2; ++n) {
                    const int ch = chb + 16 * n;
                    const size_t off = (size_t)(row0 + ai * HALF + m * 16) * 1536 + ch;
                    const u32x2 xw = *(const u32x2*)(xc + off);
                    const f32x4 ar = acc[ai][0][m][n] + *(const f32x4*)(br + ch), aiv = acc[ai][1][m][n] + *(const f32x4*)(bi + ch);
                    u32x4 w;
                    w.x = cvt_pk_bf16(fast_sigmoid(ar[0]), fast_sigmoid(aiv[0]) * bflo(xw.x));
                    w.y = cvt_pk_bf16(fast_sigmoid(ar[1]), fast_sigmoid(aiv[1]) * bfhi(xw.x));
                    w.z = cvt_pk_bf16(fast_sigmoid(ar[2]), fast_sigmoid(aiv[2]) * bflo(xw.y));
                    w.w = cvt_pk_bf16(fast_sigmoid(ar[3]), fast_sigmoid(aiv[3]) * bfhi(xw.y));
                    *(u32x4*)(RU + off) = w;
                }
                asm volatile("" ::: "memory");
            }
    }
};
__device__ __forceinline__ void st4bf(bf16_t* p, f32x4 v) { u32x2 w; w.x = cvt_pk_bf16(v[0], v[1]); w.y = cvt_pk_bf16(v[2], v[3]); *(u32x2*)p = w; }
struct EpiB1 {
    static constexpr bool PERM = false;
    bf16_t *cq, *qm, *ckv, *kpe; float *ssq_cq, *ssq_lat; const float *rs, *cosT, *sinT;
    __device__ __forceinline__ void operator()(const f32x4 (&acc)[2][2][4][2], const pg8::Unit& u, int wr, int wc, int fr, int fq) const {
        const int row0 = u.pm * 256 + wr * 64 + fr, pn = u.pn;
        if (pn == 7) {
            if (wc < 2) {
                const int j = 16 * wc + 4 * fq;
#pragma unroll
                for (int ai = 0; ai < 2; ++ai)
#pragma unroll
                    for (int m = 0; m < 4; ++m) {
                        const int row = row0 + ai * HALF + m * 16; const float s = rsqrtf(rs[row] * (1.f / DM) + EPS);
                        const f32x4 c4 = *(const f32x4*)(cosT + (size_t)row * 32 + j), s4 = *(const f32x4*)(sinT + (size_t)row * 32 + j);
                        const f32x4 x1 = acc[ai][0][m][0] * s, x2 = acc[ai][0][m][1] * s;
                        st4bf(kpe + (size_t)row * 64 + j, x1 * c4 - x2 * s4); st4bf(kpe + (size_t)row * 64 + j + 32, x2 * c4 + x1 * s4);
                    }
            }
            return;
        }
        bf16_t* O; int ldc, ocol; float cs; float* ssq;
        if (pn < 3) { O = cq; ldc = 768; ocol = pn * 256; cs = 1.f; ssq = ssq_cq; }
        else if (pn < 5) { O = qm; ldc = 512; ocol = (pn - 3) * 256; cs = MEMSCALE; ssq = nullptr; }
        else { O = ckv; ldc = 512; ocol = (pn - 5) * 256; cs = 1.f; ssq = ssq_lat; }
        ocol += wc * 32 + 4 * fq;
#pragma unroll
        for (int ai = 0; ai < 2; ++ai)
#pragma unroll
            for (int m = 0; m < 4; ++m) {
                const int row = row0 + ai * HALF + m * 16; const float s = rsqrtf(rs[row] * (1.f / DM) + EPS) * cs; float part = 0.f;
#pragma unroll
                for (int bj = 0; bj < 2; ++bj)
#pragma unroll
                    for (int n = 0; n < 2; ++n) { const f32x4 v = acc[ai][bj][m][n] * s; part += (v[0] * v[0] + v[1] * v[1]) + (v[2] * v[2] + v[3] * v[3]);
                        st4bf(O + (size_t)row * ldc + ocol + bj * HALF + 16 * n, v); }
                if (ssq) { part += __shfl_xor(part, 16); part += __shfl_xor(part, 32); if (fq == 0) atomicAdd(ssq + row, part); }
            }
    }
};
struct EpiQ {
    static constexpr bool PERM = false;
    bf16_t* Q; const float *ssq, *cosT, *sinT;
    __device__ __forceinline__ void operator()(const f32x4 (&acc)[2][2][4][2], const pg8::Unit& u, int wr, int wc, int fr, int fq) const {
        const int row0 = u.pm * 256 + wr * 64 + fr;
#pragma unroll
        for (int ai = 0; ai < 2; ++ai)
#pragma unroll
            for (int m = 0; m < 4; ++m) {
                const int row = row0 + ai * HALF + m * 16; const float s = rsqrtf(ssq[row] * (1.f / 768.f) + EPS) * QSCALE;
#pragma unroll
                for (int bj = 0; bj < 2; ++bj) {
                    const int g64 = 4 * u.pn + 2 * bj + (wc >> 1), head = g64 / 3, part = g64 - head * 3;
                    if (part < 2) {
#pragma unroll
                        for (int n = 0; n < 2; ++n) st4bf(Q + (size_t)row * 2304 + u.pn * 256 + bj * HALF + wc * 32 + 16 * n + 4 * fq, acc[ai][bj][m][n] * s);
                    } else {
                        const int j = 16 * (wc & 1) + 4 * fq;
                        const f32x4 c4 = *(const f32x4*)(cosT + (size_t)row * 32 + j), s4 = *(const f32x4*)(sinT + (size_t)row * 32 + j);
                        const f32x4 x1 = acc[ai][bj][m][0] * s, x2 = acc[ai][bj][m][1] * s;
                        bf16_t* qp = Q + (size_t)row * 2304 + head * 192 + 128 + j;
                        st4bf(qp, x1 * c4 - x2 * s4); st4bf(qp + 32, x2 * c4 + x1 * s4);
                    }
                }
            }
    }
};

template <bool BASE_F32, bool OUT_F32> struct EpiNorm {
    static constexpr bool PERM = true;
    const float* baseF; bf16_t* HBio; float* outF; const float* g; float* ssqY; float* ssqH; unsigned* cnt; int row_off; LAS float* P;
    __device__ __forceinline__ void operator()(const f32x4 (&acc)[2][2][4][2], const pg8::Unit& u, int wr, int wc, int fr_, int fq_) const {
        int fr = fr_, fq = fq_; asm volatile("" : "+v"(fr), "+v"(fq));
        const int tid = (wr * 4 + wc) * 64 + fq * 16 + fr;
        const int prow = row_off + u.pm * 256;
        const int lrow = wr * 64 + fr, col0 = u.pn * 256 + wc * 32 + 8 * fq;
        u32x4 bw[2][2];
        if (!BASE_F32) {
#pragma unroll
            for (int i = 0; i < 2; ++i)
#pragma unroll
                for (int bj = 0; bj < 2; ++bj) bw[i][bj] = *(const u32x4*)(HBio + (size_t)(prow + lrow + i * 16) * DM + col0 + bj * HALF);
        }
#pragma unroll
        for (int ai = 0; ai < 2; ++ai)
#pragma unroll
            for (int m = 0; m < 4; ++m) { float p = 0.f;
#pragma unroll
                for (int bj = 0; bj < 2; ++bj)
#pragma unroll
                    for (int n = 0; n < 2; ++n) { const f32x4 v = acc[ai][bj][m][n]; p += (v[0] * v[0] + v[1] * v[1]) + (v[2] * v[2] + v[3] * v[3]); }
                p += __shfl_xor(p, 16); p += __shfl_xor(p, 32);
                if (fq == 0) P[(ai * HALF + wr * 64 + m * 16 + fr) * 4 + wc] = p; }
        asm volatile("s_waitcnt lgkmcnt(0)" ::: "memory"); __builtin_amdgcn_s_barrier(); asm volatile("" ::: "memory");
        if (tid < 256) { const float s = (P[tid * 4 + 0] + P[tid * 4 + 1]) + (P[tid * 4 + 2] + P[tid * 4 + 3]);
            (void)__hip_atomic_fetch_add(ssqY + prow + tid, s, __ATOMIC_RELAXED, __HIP_MEMORY_SCOPE_AGENT); }
        asm volatile("s_waitcnt vmcnt(0) lgkmcnt(0)" ::: "memory"); __builtin_amdgcn_s_barrier(); asm volatile("" ::: "memory");
        if (tid == 0) { unsigned* c = cnt + 64 * ((row_off >> 8) + u.pm);
            (void)__hip_atomic_fetch_add(c, 1u, __ATOMIC_RELEASE, __HIP_MEMORY_SCOPE_AGENT);
            unsigned sp = 0; while (__hip_atomic_load(c, __ATOMIC_RELAXED, __HIP_MEMORY_SCOPE_AGENT) < 8u) { __builtin_amdgcn_s_sleep(1); if (++sp > (1u << 22)) break; }
            __builtin_amdgcn_fence(__ATOMIC_ACQUIRE, "agent");
            asm volatile("s_waitcnt vmcnt(0)" ::: "memory"); }
        __builtin_amdgcn_s_barrier(); asm volatile("" ::: "memory");
        float ry[8];
#pragma unroll
        for (int i = 0; i < 8; ++i) ry[i] = __hip_atomic_load(ssqY + prow + lrow + (i >> 2) * HALF + (i & 3) * 16, __ATOMIC_RELAXED, __HIP_MEMORY_SCOPE_AGENT);
        f32x4 gv[2][2];
#pragma unroll
        for (int bj = 0; bj < 2; ++bj) { gv[bj][0] = *(const f32x4*)(g + col0 + bj * HALF); gv[bj][1] = *(const f32x4*)(g + col0 + bj * HALF + 4); }
        asm volatile("s_waitcnt vmcnt(0)" ::: "memory");
#pragma unroll
        for (int i = 0; i < 8; ++i) ry[i] = rsqrtf(ry[i] * (1.f / DM) + EPS);
#pragma unroll
        for (int ai = 0; ai < 2; ++ai)
#pragma unroll
            for (int m = 0; m < 4; ++m) { const float r = ry[ai * 4 + m]; const size_t rowoff = (size_t)(prow + lrow + ai * HALF + m * 16) * DM + col0; float p2 = 0.f;
#pragma unroll
                for (int bj = 0; bj < 2; ++bj) { const size_t off = rowoff + bj * HALF;
                    f32x4 b0, b1;
                    if (BASE_F32) { b0 = *(const f32x4*)(baseF + off); b1 = *(const f32x4*)(baseF + off + 4); }
                    else { u32x4 w; if (m < 2) { w = bw[m][bj]; if (ai == 0) bw[m][bj] = *(const u32x4*)(HBio + off + (size_t)HALF * DM); } else w = *(const u32x4*)(HBio + off); b0 = (f32x4){bflo(w.x), bfhi(w.x), bflo(w.y), bfhi(w.y)}; b1 = (f32x4){bflo(w.z), bfhi(w.z), bflo(w.w), bfhi(w.w)}; }
                    const f32x4 h0 = b0 + acc[ai][bj][m][0] * r * gv[bj][0], h1 = b1 + acc[ai][bj][m][1] * r * gv[bj][1];
                    if (OUT_F32) { __builtin_nontemporal_store(h0, (f32x4*)(outF + off)); __builtin_nontemporal_store(h1, (f32x4*)(outF + off + 4)); }
                    else { p2 += (h0[0] * h0[0] + h0[1] * h0[1]) + (h0[2] * h0[2] + h0[3] * h0[3]) + (h1[0] * h1[0] + h1[1] * h1[1]) + (h1[2] * h1[2] + h1[3] * h1[3]);
                        u32x4 o; o.x = cvt_pk_bf16(h0[0], h0[1]); o.y = cvt_pk_bf16(h0[2], h0[3]); o.z = cvt_pk_bf16(h1[0], h1[1]); o.w = cvt_pk_bf16(h1[2], h1[3]); *(u32x4*)(HBio + off) = o; } }
                if (!OUT_F32) { p2 += __shfl_xor(p2, 16); p2 += __shfl_xor(p2, 32); if (fq == 0) P[(ai * HALF + wr * 64 + m * 16 + fr) * 4 + wc] = p2; }
                asm volatile("" ::: "memory"); }
        asm volatile("s_waitcnt lgkmcnt(0)" ::: "memory"); __builtin_amdgcn_s_barrier(); asm volatile("" ::: "memory");
        if (!OUT_F32) { if (tid < 256) { const float s = (P[tid * 4 + 0] + P[tid * 4 + 1]) + (P[tid * 4 + 2] + P[tid * 4 + 3]);
            (void)__hip_atomic_fetch_add(ssqH + prow + tid, s, __ATOMIC_RELAXED, __HIP_MEMORY_SCOPE_AGENT); } }
    }
};

constexpr int SHM_V = 16384, SHM_K = 24576, ATT_SCR = 2 * SHM_V + 2 * SHM_K;
__device__ __forceinline__ int v_st(int k, int c) { const int kk = (k & ~0xC) | ((k & 4) << 1) | ((k & 8) >> 1); return ((kk >> 3) * 4 + (c >> 5)) * 512 + ((kk & 7) * 32 + (c & 31)) * 2; }
__device__ __forceinline__ int v_rd_base(int lane) { return ((lane & 3) << 3) | (((lane >> 2) & 3) << 6) | (((lane >> 4) & 1) << 5) | (((lane >> 5) & 1) << 8); }
__device__ __forceinline__ int crow(int r, int hi) { return (r & 3) + 8 * (r >> 2) + 4 * hi; }
#define SBAR() __builtin_amdgcn_sched_barrier(0)

struct AttnArgs { const bf16_t* Q; int ldq; const bf16_t* Kn; int ldk; const bf16_t* Kp; const bf16_t* V; int ldv; bf16_t* O; int ldo; int ntiles; int cb; };

__device__ __forceinline__ void att_partialSM(f32x16& p0, f32x16& p1, float& m_reg, float& alpha) {
    float pmax = p0[0];
#pragma unroll
    for (int r = 1; r < 16; ++r) pmax = fmaxf(pmax, p0[r]);
#pragma unroll
    for (int r = 0; r < 16; ++r) pmax = fmaxf(pmax, p1[r]);
    { auto rr = __builtin_amdgcn_permlane32_swap(__float_as_uint(pmax), __float_as_uint(pmax), false, false);
      pmax = fmaxf(__uint_as_float(rr[0]), __uint_as_float(rr[1])); }
    float mn;
    if (__all((pmax - m_reg) <= 11.f)) { mn = m_reg; alpha = 1.f; }
    else { mn = fmaxf(m_reg, pmax); alpha = __builtin_amdgcn_exp2f(m_reg - mn); m_reg = mn; }
#pragma unroll
    for (int r = 0; r < 16; ++r) { p0[r] = __builtin_amdgcn_exp2f(p0[r] - mn); p1[r] = __builtin_amdgcn_exp2f(p1[r] - mn); }
}
__device__ __forceinline__ void att_finishSM(const f32x16& p0, const f32x16& p1, float alpha, float& l_reg, bf16x8& pa0, bf16x8& pa1, bf16x8& pa2, bf16x8& pa3) {
    float ps = 0.f;
#pragma unroll
    for (int r = 0; r < 16; ++r) ps += p0[r] + p1[r];
    { auto rr = __builtin_amdgcn_permlane32_swap(__float_as_uint(ps), __float_as_uint(ps), false, false);
      ps = __uint_as_float(rr[0]) + __uint_as_float(rr[1]); }
    l_reg = l_reg * alpha + ps;
#define PK4(P, B_, OUT) do { unsigned a0 = cvt_pk_bf16(P[B_+0], P[B_+1]), a1 = cvt_pk_bf16(P[B_+2], P[B_+3]);                          \
        unsigned b0 = cvt_pk_bf16(P[B_+4], P[B_+5]), b1 = cvt_pk_bf16(P[B_+6], P[B_+7]);                                             \
        auto r0 = __builtin_amdgcn_permlane32_swap(a0, b0, false, false); auto r1 = __builtin_amdgcn_permlane32_swap(a1, b1, false, false); \
        u32x4 w = {r0[0], r1[0], r0[1], r1[1]}; OUT = *reinterpret_cast<bf16x8*>(&w); } while (0)
    PK4(p0, 0, pa0); PK4(p0, 8, pa1); PK4(p1, 0, pa2); PK4(p1, 8, pa3);
#undef PK4
}
template <int KB, int NKC>
__device__ __forceinline__ void att_qkt(f32x16& p0, f32x16& p1, const char* K_lds, int r32, int hi, const bf16x8* qr) {
    p0 = f32x16{}; p1 = f32x16{};
    const int x = (r32 >> 1) & 7;
    const char* kb[4];
#pragma unroll
    for (int dd = 0; dd < 4; ++dd) kb[dd] = K_lds + KB * SHM_K + r32 * 128 + (((dd * 2 + hi) ^ x) << 4);
#pragma unroll
    for (int d0 = 0; d0 < NKC; ++d0) { const char* a = kb[d0 & 3] + (d0 >> 2) * 8192;
        const bf16x8 b0 = *reinterpret_cast<const bf16x8*>(a);
        const bf16x8 b1 = *reinterpret_cast<const bf16x8*>(a + 4096);
        p0 = __builtin_amdgcn_mfma_f32_32x32x16_bf16(b0, qr[d0], p0, 0, 0, 0);
        p1 = __builtin_amdgcn_mfma_f32_32x32x16_bf16(b1, qr[d0], p1, 0, 0, 0); }
}
template <int VB>
__device__ __forceinline__ void att_pv(f32x16* o, int vb0, bf16x8 pa0, bf16x8 pa1, bf16x8 pa2, bf16x8 pa3) {
#define TRRD(dst, off) asm volatile("ds_read_b64_tr_b16 %0, %1 offset:%2" : "=&v"(dst) : "v"(vb0), "i"(off) : "memory")
#define PV_D0(d0) do { s16x4 l0, l1, l2, l3, h0, h1, h2, h3; constexpr int b_ = VB * SHM_V + (d0) * 512; \
        TRRD(l0, b_); TRRD(h0, b_ + 2048); TRRD(l1, b_ + 4096); TRRD(h1, b_ + 6144); TRRD(l2, b_ + 8192); TRRD(h2, b_ + 10240); TRRD(l3, b_ + 12288); TRRD(h3, b_ + 14336); \
        asm volatile("s_waitcnt lgkmcnt(0)" ::: "memory"); SBAR(); \
        o[d0] = __builtin_amdgcn_mfma_f32_32x32x16_bf16(pa0, (bf16x8){l0[0], l0[1], l0[2], l0[3], h0[0], h0[1], h0[2], h0[3]}, o[d0], 0, 0, 0);   \
        o[d0] = __builtin_amdgcn_mfma_f32_32x32x16_bf16(pa1, (bf16x8){l1[0], l1[1], l1[2], l1[3], h1[0], h1[1], h1[2], h1[3]}, o[d0], 0, 0, 0);   \
        o[d0] = __builtin_amdgcn_mfma_f32_32x32x16_bf16(pa2, (bf16x8){l2[0], l2[1], l2[2], l2[3], h2[0], h2[1], h2[2], h2[3]}, o[d0], 0, 0, 0);   \
        o[d0] = __builtin_amdgcn_mfma_f32_32x32x16_bf16(pa3, (bf16x8){l3[0], l3[1], l3[2], l3[3], h3[0], h3[1], h3[2], h3[3]}, o[d0], 0, 0, 0); } while (0)
    PV_D0(0); PV_D0(1); PV_D0(2); PV_D0(3);
#undef PV_D0
#undef TRRD
}

template <int NKC>
__device__ __forceinline__ void attn_unit(const AttnArgs& a, char* lds) {
    constexpr bool PE = NKC > 8;
    int tid_ = threadIdx.x; asm volatile("" : "+v"(tid_));
    const int tid = tid_, wid = __builtin_amdgcn_readfirstlane(tid >> 6), lane = tid & 63, r32 = lane & 31, hi = lane >> 5;
    char* V_lds = lds; char* K_lds = lds + 2 * SHM_V;
    float* wsf = (float*)(lds + ATT_SCR) + wid * 64; float* li_l = wsf; float* al_l = wsf + 32;
    const int sr = tid >> 4, c16 = tid & 15, sc = c16 * 8;
    const int vst0 = v_st(sr, sc), vst1 = v_st(32 + sr, sc);
    const int kws = (c16 >> 3) * 8192 + sr * 128 + (((c16 & 7) ^ ((sr >> 1) & 7)) << 4);
    const int pkey = tid >> 3, pws = 16384 + pkey * 128 + (((tid & 7) ^ ((pkey >> 1) & 7)) << 4);
    const int vb0 = (int)(uintptr_t)V_lds + v_rd_base(lane);
    const int mytiles = min(a.ntiles, a.cb + (wid >> 1) + 1);
    bf16x8 qr[NKC];
#pragma unroll
    for (int d0 = 0; d0 < NKC; ++d0) qr[d0] = *(const bf16x8*)(a.Q + (size_t)(wid * 32 + r32) * a.ldq + d0 * 16 + hi * 8);
    bf16x8 st_k0, st_k1, st_v0, st_v1, st_p;
#define ALOAD(t) do { const size_t k0_ = (size_t)(t) * 64; \
        st_k0 = *(const bf16x8*)(a.Kn + (k0_ + sr) * a.ldk + sc); st_k1 = *(const bf16x8*)(a.Kn + (k0_ + 32 + sr) * a.ldk + sc); \
        st_v0 = *(const bf16x8*)(a.V + (k0_ + sr) * a.ldv + sc); st_v1 = *(const bf16x8*)(a.V + (k0_ + 32 + sr) * a.ldv + sc); \
        if constexpr (PE) st_p = *(const bf16x8*)(a.Kp + (k0_ + pkey) * 64 + (tid & 7) * 8); } while (0)
#define AWRITE(bf) do { *(bf16x8*)(K_lds + (bf) * SHM_K + kws) = st_k0; *(bf16x8*)(K_lds + (bf) * SHM_K + kws + 4096) = st_k1; \
        *(bf16x8*)(V_lds + (bf) * SHM_V + vst0) = st_v0; *(bf16x8*)(V_lds + (bf) * SHM_V + vst1) = st_v1; \
        if constexpr (PE) *(bf16x8*)(K_lds + (bf) * SHM_K + pws) = st_p; } while (0)
    float m_reg = -1e30f, l_reg = 0.f; f32x16 o[4] = {};
    ALOAD(0); AWRITE(0);
    __syncthreads();
#define ATILE(t, BF) do { \
        if ((t) + 1 < a.ntiles) ALOAD((t) + 1); \
        if ((t) < mytiles) { f32x16 p0, p1; float alpha; bf16x8 pa0, pa1, pa2, pa3; \
            att_qkt<BF, NKC>(p0, p1, K_lds, r32, hi, qr); \
            att_partialSM(p0, p1, m_reg, alpha); \
            if (__any(alpha < 1.f)) { if (hi == 0) al_l[r32] = alpha; asm volatile("s_waitcnt lgkmcnt(0)" ::: "memory"); \
                _Pragma("unroll") for (int d_ = 0; d_ < 4; ++d_) _Pragma("unroll") for (int r = 0; r < 16; ++r) o[d_][r] *= al_l[crow(r, hi)]; } \
            att_finishSM(p0, p1, alpha, l_reg, pa0, pa1, pa2, pa3); SBAR(); \
            att_pv<BF>(o, vb0, pa0, pa1, pa2, pa3); } \
        if ((t) + 1 < a.ntiles) AWRITE(1 - (BF)); \
        __syncthreads(); } while (0)
    for (int t = 0; t < a.ntiles; t += 2) {
        ATILE(t, 0);
        if (t + 1 < a.ntiles) ATILE(t + 1, 1);
    }
#undef ATILE
#undef ALOAD
#undef AWRITE
    if (hi == 0) li_l[r32] = l_reg; asm volatile("s_waitcnt lgkmcnt(0)" ::: "memory");
    float rli[16];
#pragma unroll
    for (int r = 0; r < 16; ++r) rli[r] = __builtin_amdgcn_rcpf(li_l[crow(r, hi)]);
    bf16_t* Ow = a.O + (size_t)(wid * 32) * a.ldo;
#pragma unroll
    for (int r = 0; r < 16; ++r) { const int orow = crow(r, hi);
#pragma unroll
        for (int d0 = 0; d0 < 4; ++d0) { const float v = o[d0][r] * rli[r];
            const float vn = __shfl_xor(v, 1);
            if ((r32 & 1) == 0) *(unsigned*)(Ow + (size_t)orow * a.ldo + d0 * 32 + r32) = cvt_pk_bf16(v, vn); } }
    __syncthreads();
}

#define XB_TMO      128
#define XB_XCNT(j)  (256  + 64 * (j))
#define XB_XSUB(j)  (1280 + 64 * (j))
#define XB_XGEN(j)  (2304 + 64 * (j))
#define XB_TOP      3328
#define XB_TOPGEN   3392
#define XCD_BAR_WORDS 3456
#define XB_SPIN_CAP (1u << 18)

__device__ __forceinline__ unsigned xb_ld(unsigned* p)              { return __hip_atomic_load(p, __ATOMIC_RELAXED, __HIP_MEMORY_SCOPE_AGENT); }
__device__ __forceinline__ unsigned xb_add(unsigned* p, unsigned v) { return __hip_atomic_fetch_add(p, v, __ATOMIC_RELAXED, __HIP_MEMORY_SCOPE_AGENT); }
__device__ __forceinline__ unsigned xb_xcc_id() { return (unsigned)__builtin_amdgcn_s_getreg((3 << 11) | 20) & 0xFu; }
#define XB_SPIN(cond, bar) do { unsigned _sp = 0; while (cond) { __builtin_amdgcn_s_sleep(1); \
    if ((++_sp & 255u) == 0u) { if (xb_ld(&(bar)[XB_TMO])) break; if (_sp > XB_SPIN_CAP) { atomicAdd(&(bar)[XB_TMO], 1u); break; } } } } while (0)

struct XcdBarrier {
    unsigned* bar; unsigned x;
    volatile LAS unsigned* st;
};

__device__ __forceinline__ XcdBarrier xcd_barrier_post(unsigned* bar, volatile LAS unsigned* st) {
    XcdBarrier b; b.bar = bar; b.x = xb_xcc_id(); b.st = st;
    if (threadIdx.x == 0) (void)xb_add(&bar[XB_XCNT(b.x)], 1u);
    return b;
}
__device__ __forceinline__ void xcd_barrier_complete(unsigned* bar, unsigned x, unsigned& nloc, unsigned& nx) {
    const unsigned G = gridDim.x * gridDim.y * gridDim.z;
    unsigned sum, cnt, mine, sp = 0u;
    for (;;) {
        sum = 0u; cnt = 0u; mine = 0u;
#pragma unroll
        for (unsigned j = 0; j < 16; ++j) { const unsigned c = xb_ld(&bar[XB_XCNT(j)]); sum += c; cnt += (c > 0u) ? 1u : 0u; mine = (j == x) ? c : mine; }
        if (sum == G) break;
        __builtin_amdgcn_s_sleep(1);
        if ((++sp & 255u) == 0u) { if (xb_ld(&bar[XB_TMO])) break; if (sp > XB_SPIN_CAP) { atomicAdd(&bar[XB_TMO], 1u); break; } }
    }
    nloc = mine > 0u ? mine : 1u; nx = cnt > 0u ? cnt : 1u;
}

__device__ __forceinline__ void xcd_barrier(const XcdBarrier& b) {
    asm volatile("s_waitcnt vmcnt(0)" ::: "memory");
    __syncthreads();
    if (threadIdx.x == 0) {
        unsigned* bar = b.bar;
        __builtin_amdgcn_s_waitcnt(0);
        unsigned nloc = b.st[0], nx = b.st[1];
        if (nloc == 0u) { xcd_barrier_complete(bar, b.x, nloc, nx); b.st[0] = nloc; b.st[1] = nx; }
        const unsigned old = xb_add(&bar[XB_XSUB(b.x)], 1u);
        const unsigned gen = old / nloc;
        if (old + 1u == (gen + 1u) * nloc) {
            __builtin_amdgcn_fence(__ATOMIC_RELEASE, "agent");
            asm volatile("s_waitcnt vmcnt(0)" ::: "memory");
            const unsigned og = xb_add(&bar[XB_TOP], 1u);
            const unsigned tg = og / nx;
            if (og + 1u == (tg + 1u) * nx) xb_add(&bar[XB_TOPGEN], 1u);
            else XB_SPIN(xb_ld(&bar[XB_TOPGEN]) == tg, bar);
            __builtin_amdgcn_fence(__ATOMIC_ACQUIRE, "agent");
            xb_add(&bar[XB_XGEN(b.x)], 1u);
            asm volatile("s_waitcnt vmcnt(0)" ::: "memory");
        } else {
            XB_SPIN(xb_ld(&bar[XB_XGEN(b.x)]) == gen, bar);
            __builtin_amdgcn_fence(__ATOMIC_ACQUIRE, "agent");
            asm volatile("s_waitcnt vmcnt(0)" ::: "memory");
        }
    }
    __syncthreads();
}

constexpr int ATT_SLOTS = 8;
__device__ const unsigned short g_att_sched[256][ATT_SLOTS] = {
{15,518,512,1056,1200,65535,65535,65535},
{31,534,528,1057,1201,65535,65535,65535},
{47,550,544,1058,1202,65535,65535,65535},
{63,566,560,1059,1203,65535,65535,65535},
{79,582,576,1060,1204,65535,65535,65535},
{95,598,592,1061,1205,65535,65535,65535},
{111,614,608,1062,1206,65535,65535,65535},
{127,630,624,1063,1207,65535,65535,65535},
{143,646,640,1064,1208,65535,65535,65535},
{159,662,656,1065,1209,65535,65535,65535},
{175,678,672,1066,1210,65535,65535,65535},
{191,694,688,1067,1211,65535,65535,65535},
{207,710,704,1068,1212,65535,65535,65535},
{223,726,720,1069,1213,65535,65535,65535},
{239,742,736,1070,1214,65535,65535,65535},
{255,758,752,1071,1215,65535,65535,65535},
{271,5,514,1152,65535,65535,65535,65535},
{287,21,530,1153,65535,65535,65535,65535},
{303,37,546,1154,65535,65535,65535,65535},
{319,53,562,1155,65535,65535,65535,65535},
{335,69,578,1156,65535,65535,65535,65535},
{351,85,594,1157,65535,65535,65535,65535},
{367,101,610,1158,65535,65535,65535,65535},
{383,117,626,1159,65535,65535,65535,65535},
{399,133,642,1160,65535,65535,65535,65535},
{415,149,658,1161,65535,65535,65535,65535},
{431,165,674,1162,65535,65535,65535,65535},
{447,181,690,1163,65535,65535,65535,65535},
{463,197,706,1164,65535,65535,65535,65535},
{479,213,722,1165,65535,65535,65535,65535},
{495,229,738,1166,65535,65535,65535,65535},
{511,245,754,1167,65535,65535,65535,65535},
{527,261,1,1072,1216,65535,65535,65535},
{543,277,17,1073,1217,65535,65535,65535},
{559,293,33,1074,1218,65535,65535,65535},
{575,309,49,1075,1219,65535,65535,65535},
{591,325,65,1076,1220,65535,65535,65535},
{607,341,81,1077,1221,65535,65535,65535},
{623,357,97,1078,1222,65535,65535,65535},
{639,373,113,1079,1223,65535,65535,65535},
{655,389,129,1080,1224,65535,65535,65535},
{671,405,145,1081,1225,65535,65535,65535},
{687,421,161,1082,1226,65535,65535,65535},
{703,437,177,1083,1227,65535,65535,65535},
{719,453,193,1084,1228,65535,65535,65535},
{735,469,209,1085,1229,65535,65535,65535},
{751,485,225,1086,1230,65535,65535,65535},
{767,501,241,1087,1231,65535,65535,65535},
{14,519,257,1088,65535,65535,65535,65535},
{30,535,273,1089,65535,65535,65535,65535},
{46,551,289,1090,65535,65535,65535,65535},
{62,567,305,1091,65535,65535,65535,65535},
{78,583,321,1092,65535,65535,65535,65535},
{94,599,337,1093,65535,65535,65535,65535},
{110,615,353,1094,65535,65535,65535,65535},
{126,631,369,1095,65535,65535,65535,65535},
{142,647,385,1096,65535,65535,65535,65535},
{158,663,401,1097,65535,65535,65535,65535},
{174,679,417,1098,65535,65535,65535,65535},
{190,695,433,1099,65535,65535,65535,65535},
{206,711,449,1100,65535,65535,65535,65535},
{222,727,465,1101,65535,65535,65535,65535},
{238,743,481,1102,65535,65535,65535,65535},
{254,759,497,1103,65535,65535,65535,65535},
{13,6,517,65535,65535,65535,65535,65535},
{29,22,533,65535,65535,65535,65535,65535},
{45,38,549,65535,65535,65535,65535,65535},
{61,54,565,65535,65535,65535,65535,65535},
{77,70,581,65535,65535,65535,65535,65535},
{93,86,597,65535,65535,65535,65535,65535},
{109,102,613,65535,65535,65535,65535,65535},
{125,118,629,65535,65535,65535,65535,65535},
{141,134,645,65535,65535,65535,65535,65535},
{157,150,661,65535,65535,65535,65535,65535},
{173,166,677,65535,65535,65535,65535,65535},
{189,182,693,65535,65535,65535,65535,65535},
{205,198,709,65535,65535,65535,65535,65535},
{221,214,725,65535,65535,65535,65535,65535},
{237,230,741,65535,65535,65535,65535,65535},
{253,246,757,65535,65535,65535,65535,65535},
{526,262,4,65535,65535,65535,65535,65535},
{542,278,20,65535,65535,65535,65535,65535},
{558,294,36,65535,65535,65535,65535,65535},
{574,310,52,65535,65535,65535,65535,65535},
{590,326,68,65535,65535,65535,65535,65535},
{606,342,84,65535,65535,65535,65535,65535},
{622,358,100,65535,65535,65535,65535,65535},
{638,374,116,65535,65535,65535,65535,65535},
{654,390,132,65535,65535,65535,65535,65535},
{670,406,148,65535,65535,65535,65535,65535},
{686,422,164,65535,65535,65535,65535,65535},
{702,438,180,65535,65535,65535,65535,65535},
{718,454,196,65535,65535,65535,65535,65535},
{734,470,212,65535,65535,65535,65535,65535},
{750,486,228,65535,65535,65535,65535,65535},
{766,502,244,65535,65535,65535,65535,65535},
{270,520,513,1104,65535,65535,65535,65535},
{286,536,529,1105,65535,65535,65535,65535},
{302,552,545,1106,65535,65535,65535,65535},
{318,568,561,1107,65535,65535,65535,65535},
{334,584,577,1108,65535,65535,65535,65535},
{350,600,593,1109,65535,65535,65535,65535},
{366,616,609,1110,65535,65535,65535,65535},
{382,632,625,1111,65535,65535,65535,65535},
{398,648,641,1112,65535,65535,65535,65535},
{414,664,657,1113,65535,65535,65535,65535},
{430,680,673,1114,65535,65535,65535,65535},
{446,696,689,1115,65535,65535,65535,65535},
{462,712,705,1116,65535,65535,65535,65535},
{478,728,721,1117,65535,65535,65535,65535},
{494,744,737,1118,65535,65535,65535,65535},
{510,760,753,1119,65535,65535,65535,65535},
{269,7,260,65535,65535,65535,65535,65535},
{285,23,276,65535,65535,65535,65535,65535},
{301,39,292,65535,65535,65535,65535,65535},
{317,55,308,65535,65535,65535,65535,65535},
{333,71,324,65535,65535,65535,65535,65535},
{349,87,340,65535,65535,65535,65535,65535},
{365,103,356,65535,65535,65535,65535,65535},
{381,119,372,65535,65535,65535,65535,65535},
{397,135,388,65535,65535,65535,65535,65535},
{413,151,404,65535,65535,65535,65535,65535},
{429,167,420,65535,65535,65535,65535,65535},
{445,183,436,65535,65535,65535,65535,65535},
{461,199,452,65535,65535,65535,65535,65535},
{477,215,468,65535,65535,65535,65535,65535},
{493,231,484,65535,65535,65535,65535,65535},
{509,247,500,65535,65535,65535,65535,65535},
{525,263,516,65535,65535,65535,65535,65535},
{541,279,532,65535,65535,65535,65535,65535},
{557,295,548,65535,65535,65535,65535,65535},
{573,311,564,65535,65535,65535,65535,65535},
{589,327,580,65535,65535,65535,65535,65535},
{605,343,596,65535,65535,65535,65535,65535},
{621,359,612,65535,65535,65535,65535,65535},
{637,375,628,65535,65535,65535,65535,65535},
{653,391,644,65535,65535,65535,65535,65535},
{669,407,660,65535,65535,65535,65535,65535},
{685,423,676,65535,65535,65535,65535,65535},
{701,439,692,65535,65535,65535,65535,65535},
{717,455,708,65535,65535,65535,65535,65535},
{733,471,724,65535,65535,65535,65535,65535},
{749,487,740,65535,65535,65535,65535,65535},
{765,503,756,65535,65535,65535,65535,65535},
{12,521,0,1024,1168,65535,65535,65535},
{28,537,16,1025,1169,65535,65535,65535},
{44,553,32,1026,1170,65535,65535,65535},
{60,569,48,1027,1171,65535,65535,65535},
{76,585,64,1028,1172,65535,65535,65535},
{92,601,80,1029,1173,65535,65535,65535},
{108,617,96,1030,1174,65535,65535,65535},
{124,633,112,1031,1175,65535,65535,65535},
{140,649,128,1032,1176,65535,65535,65535},
{156,665,144,1033,1177,65535,65535,65535},
{172,681,160,1034,1178,65535,65535,65535},
{188,697,176,1035,1179,65535,65535,65535},
{204,713,192,1036,1180,65535,65535,65535},
{220,729,208,1037,1181,65535,65535,65535},
{236,745,224,1038,1182,65535,65535,65535},
{252,761,240,1039,1183,65535,65535,65535},
{268,8,3,1232,65535,65535,65535,65535},
{284,24,19,1233,65535,65535,65535,65535},
{300,40,35,1234,65535,65535,65535,65535},
{316,56,51,1235,65535,65535,65535,65535},
{332,72,67,1236,65535,65535,65535,65535},
{348,88,83,1237,65535,65535,65535,65535},
{364,104,99,1238,65535,65535,65535,65535},
{380,120,115,1239,65535,65535,65535,65535},
{396,136,131,1240,65535,65535,65535,65535},
{412,152,147,1241,65535,65535,65535,65535},
{428,168,163,1242,65535,65535,65535,65535},
{444,184,179,1243,65535,65535,65535,65535},
{460,200,195,1244,65535,65535,65535,65535},
{476,216,211,1245,65535,65535,65535,65535},
{492,232,227,1246,65535,65535,65535,65535},
{508,248,243,1247,65535,65535,65535,65535},
{524,264,259,1248,65535,65535,65535,65535},
{540,280,275,1249,65535,65535,65535,65535},
{556,296,291,1250,65535,65535,65535,65535},
{572,312,307,1251,65535,65535,65535,65535},
{588,328,323,1252,65535,65535,65535,65535},
{604,344,339,1253,65535,65535,65535,65535},
{620,360,355,1254,65535,65535,65535,65535},
{636,376,371,1255,65535,65535,65535,65535},
{652,392,387,1256,65535,65535,65535,65535},
{668,408,403,1257,65535,65535,65535,65535},
{684,424,419,1258,65535,65535,65535,65535},
{700,440,435,1259,65535,65535,65535,65535},
{716,456,451,1260,65535,65535,65535,65535},
{732,472,467,1261,65535,65535,65535,65535},
{748,488,483,1262,65535,65535,65535,65535},
{764,504,499,1263,65535,65535,65535,65535},
{11,522,256,1040,1184,65535,65535,65535},
{27,538,272,1041,1185,65535,65535,65535},
{43,554,288,1042,1186,65535,65535,65535},
{59,570,304,1043,1187,65535,65535,65535},
{75,586,320,1044,1188,65535,65535,65535},
{91,602,336,1045,1189,65535,65535,65535},
{107,618,352,1046,1190,65535,65535,65535},
{123,634,368,1047,1191,65535,65535,65535},
{139,650,384,1048,1192,65535,65535,65535},
{155,666,400,1049,1193,65535,65535,65535},
{171,682,416,1050,1194,65535,65535,65535},
{187,698,432,1051,1195,65535,65535,65535},
{203,714,448,1052,1196,65535,65535,65535},
{219,730,464,1053,1197,65535,65535,65535},
{235,746,480,1054,1198,65535,65535,65535},
{251,762,496,1055,1199,65535,65535,65535},
{267,9,515,1264,65535,65535,65535,65535},
{283,25,531,1265,65535,65535,65535,65535},
{299,41,547,1266,65535,65535,65535,65535},
{315,57,563,1267,65535,65535,65535,65535},
{331,73,579,1268,65535,65535,65535,65535},
{347,89,595,1269,65535,65535,65535,65535},
{363,105,611,1270,65535,65535,65535,65535},
{379,121,627,1271,65535,65535,65535,65535},
{395,137,643,1272,65535,65535,65535,65535},
{411,153,659,1273,65535,65535,65535,65535},
{427,169,675,1274,65535,65535,65535,65535},
{443,185,691,1275,65535,65535,65535,65535},
{459,201,707,1276,65535,65535,65535,65535},
{475,217,723,1277,65535,65535,65535,65535},
{491,233,739,1278,65535,65535,65535,65535},
{507,249,755,1279,65535,65535,65535,65535},
{523,265,2,1120,65535,65535,65535,65535},
{539,281,18,1121,65535,65535,65535,65535},
{555,297,34,1122,65535,65535,65535,65535},
{571,313,50,1123,65535,65535,65535,65535},
{587,329,66,1124,65535,65535,65535,65535},
{603,345,82,1125,65535,65535,65535,65535},
{619,361,98,1126,65535,65535,65535,65535},
{635,377,114,1127,65535,65535,65535,65535},
{651,393,130,1128,65535,65535,65535,65535},
{667,409,146,1129,65535,65535,65535,65535},
{683,425,162,1130,65535,65535,65535,65535},
{699,441,178,1131,65535,65535,65535,65535},
{715,457,194,1132,65535,65535,65535,65535},
{731,473,210,1133,65535,65535,65535,65535},
{747,489,226,1134,65535,65535,65535,65535},
{763,505,242,1135,65535,65535,65535,65535},
{10,266,258,1136,65535,65535,65535,65535},
{26,282,274,1137,65535,65535,65535,65535},
{42,298,290,1138,65535,65535,65535,65535},
{58,314,306,1139,65535,65535,65535,65535},
{74,330,322,1140,65535,65535,65535,65535},
{90,346,338,1141,65535,65535,65535,65535},
{106,362,354,1142,65535,65535,65535,65535},
{122,378,370,1143,65535,65535,65535,65535},
{138,394,386,1144,65535,65535,65535,65535},
{154,410,402,1145,65535,65535,65535,65535},
{170,426,418,1146,65535,65535,65535,65535},
{186,442,434,1147,65535,65535,65535,65535},
{202,458,450,1148,65535,65535,65535,65535},
{218,474,466,1149,65535,65535,65535,65535},
{234,490,482,1150,65535,65535,65535,65535},
{250,506,498,1151,65535,65535,65535,65535}};

struct Args {
    const float *x, *mem; const int* pos;
    const float *g_mix_pre, *g_mix_post, *g_mlp_pre, *g_mlp_post, *g_mem, *w_mem_k, *w_mem_v, *w_o, *w_ff1, *w_ff2;
    const float *a_w_in, *a_conv_w, *a_conv_b, *a_w_r, *a_b_r, *a_w_i, *a_b_i, *a_lambda;
    const float *b_w_in, *b_g_qa, *b_w_qb, *kv_g_in, *kv_w_down, *kv_g_latent, *kv_w_up;
    float* out; unsigned char* ws;
    float invf[32];
    int ph_lo, ph_hi;
};

__device__ __forceinline__ int rope_pos(int j) { return 32 * ((j >> 4) & 1) + 16 * (j >> 5) + (j & 15); }
__device__ __forceinline__ void tr_load(const float* W, int ldw, int scol0, int ncols, int item, int lane, float (&v)[32]) {
    const int nblk = ncols / 32, kb = item / nblk, nb = item - kb * nblk, k0 = 64 * kb, n0 = 32 * nb;
    const float* wp = W + (size_t)(k0 + (lane >> 5)) * ldw + scol0 + n0 + (lane & 31);
#pragma unroll
    for (int i = 0; i < 32; ++i) v[i] = __builtin_nontemporal_load(wp + (size_t)(2 * i) * ldw);
}
__device__ __forceinline__ void tr_store(const float (&v)[32], int ncols, const float* gain, bf16_t* WT, int ldk, int koff, int kind, int rbase, LAS float* scr, int item, int lane, bool far = false) {
    const int nblk = ncols / 32, kb = item / nblk, nb = item - kb * nblk, k0 = 64 * kb, n0 = 32 * nb;
    const int c = lane & 7;
    f32x4 g0 = {1.f, 1.f, 1.f, 1.f}, g1 = g0;
    if (gain) { g0 = *(const f32x4*)(gain + k0 + 8 * c); g1 = *(const f32x4*)(gain + k0 + 8 * c + 4); }
#pragma unroll
    for (int i = 0; i < 32; ++i) scr[(2 * i + (lane >> 5)) * 33 + (lane & 31)] = v[i];
    asm volatile("s_waitcnt lgkmcnt(0)" ::: "memory");
#pragma unroll
    for (int j = 0; j < 4; ++j) { const int n = (lane >> 3) + 8 * j; const LAS float* s = scr + (8 * c) * 33 + n;
        u32x4 o; o.x = cvt_pk_bf16(s[0 * 33] * g0[0], s[1 * 33] * g0[1]); o.y = cvt_pk_bf16(s[2 * 33] * g0[2], s[3 * 33] * g0[3]);
        o.z = cvt_pk_bf16(s[4 * 33] * g1[0], s[5 * 33] * g1[1]); o.w = cvt_pk_bf16(s[6 * 33] * g1[2], s[7 * 33] * g1[3]);
        const int nn = n0 + n; int drow;
        if (kind == 0) drow = rbase + nn;
        else if (kind == 1) { const int head = nn / 192, w = nn - head * 192; drow = head * 192 + (w >= 128 ? 128 + rope_pos(w - 128) : w); }
        else drow = rbase + rope_pos(nn);
        if (far) __builtin_nontemporal_store(o, (u32x4*)(WT + (size_t)drow * ldk + koff + k0 + 8 * c)); else *(u32x4*)(WT + (size_t)drow * ldk + koff + k0 + 8 * c) = o; }
    asm volatile("s_waitcnt lgkmcnt(0)" ::: "memory");
}
__device__ __forceinline__ void tr_job(int& it, int stride, const float* W, int ldw, int scol0, int ncols, int K, const float* gain, bf16_t* WT, int ldk, int koff, int kind, int rbase, LAS float* scr, int lane, bool far = false) {
    const int ni = (K / 64) * (ncols / 32);
    if (it < ni) { float v[32]; tr_load(W, ldw, scol0, ncols, it, lane, v);
        for (;;) { const int nx = it + stride; float w[32];
            if (nx < ni) tr_load(W, ldw, scol0, ncols, nx, lane, w);
            tr_store(v, ncols, gain, WT, ldk, koff, kind, rbase, scr, it, lane, far);
            it = nx; if (nx >= ni) break;
#pragma unroll
            for (int i = 0; i < 32; ++i) v[i] = w[i]; } }
    it -= ni;
}
__device__ __forceinline__ void cvt_rows(const float* src, bf16_t* dst, float* rstd, int nrows, int gw, int NGW, int lane) {
    for (int row = gw; row < nrows; row += NGW) {
        const float* xr = src + (size_t)row * DM; float ss = 0.f;
#pragma unroll
        for (int j = 0; j < 4; ++j) { const int col = (lane + 64 * j) * 8; const f32x4 a = *(const f32x4*)(xr + col), b = *(const f32x4*)(xr + col + 4);
            ss += (a[0] * a[0] + a[1] * a[1]) + (a[2] * a[2] + a[3] * a[3]) + (b[0] * b[0] + b[1] * b[1]) + (b[2] * b[2] + b[3] * b[3]);
            u32x4 w; w.x = cvt_pk_bf16(a[0], a[1]); w.y = cvt_pk_bf16(a[2], a[3]); w.z = cvt_pk_bf16(b[0], b[1]); w.w = cvt_pk_bf16(b[2], b[3]);
            *(u32x4*)(dst + (size_t)row * DM + col) = w; }
        ss = wave_sum(ss);
        if (lane == 0) rstd[row] = rsqrtf(ss * (1.f / DM) + EPS);
    }
}
template <bool BASE_F32, bool OUT_F32>
__device__ __forceinline__ void row_pass(const bf16_t* Y, const float* baseF, const float* g, float* outF, bf16_t* HBio, float* rstd_out, int gw, int NGW, int lane) {
    for (int row = gw; row < T; row += NGW) {
        const u32x4* yr = (const u32x4*)(Y + (size_t)row * DM) + lane;
        u32x4 yw[4]; u32x4 bw[4]; float ss = 0.f;
#pragma unroll
        for (int j = 0; j < 4; ++j) yw[j] = yr[64 * j];
        if (!BASE_F32) {
#pragma unroll
            for (int j = 0; j < 4; ++j) bw[j] = ((const u32x4*)(HBio + (size_t)row * DM) + lane)[64 * j]; }
#pragma unroll
        for (int j = 0; j < 4; ++j) { const u32x4 w = yw[j];
            ss += bflo(w.x) * bflo(w.x) + bfhi(w.x) * bfhi(w.x) + bflo(w.y) * bflo(w.y) + bfhi(w.y) * bfhi(w.y) + bflo(w.z) * bflo(w.z) + bfhi(w.z) * bfhi(w.z) + bflo(w.w) * bflo(w.w) + bfhi(w.w) * bfhi(w.w); }
        ss = wave_sum(ss);
        const float ry = rsqrtf(ss * (1.f / DM) + EPS); float ss2 = 0.f;
#pragma unroll
        for (int j = 0; j < 4; ++j) { const int col = (lane + 64 * j) * 8; const size_t off = (size_t)row * DM + col;
            f32x4 b0, b1;
            if (BASE_F32) { b0 = *(const f32x4*)(baseF + off); b1 = *(const f32x4*)(baseF + off + 4); }
            else { const u32x4 w = bw[j]; b0 = (f32x4){bflo(w.x), bfhi(w.x), bflo(w.y), bfhi(w.y)}; b1 = (f32x4){bflo(w.z), bfhi(w.z), bflo(w.w), bfhi(w.w)}; }
            const f32x4 g0 = *(const f32x4*)(g + col), g1 = *(const f32x4*)(g + col + 4);
            const u32x4 w = yw[j];
            const f32x4 y0 = {bflo(w.x), bfhi(w.x), bflo(w.y), bfhi(w.y)}, y1 = {bflo(w.z), bfhi(w.z), bflo(w.w), bfhi(w.w)};
            const f32x4 h0 = b0 + y0 * ry * g0, h1 = b1 + y1 * ry * g1;
            if (OUT_F32) { *(f32x4*)(outF + off) = h0; *(f32x4*)(outF + off + 4) = h1; }
            else { ss2 += (h0[0] * h0[0] + h0[1] * h0[1]) + (h0[2] * h0[2] + h0[3] * h0[3]) + (h1[0] * h1[0] + h1[1] * h1[1]) + (h1[2] * h1[2] + h1[3] * h1[3]);
                u32x4 o; o.x = cvt_pk_bf16(h0[0], h0[1]); o.y = cvt_pk_bf16(h0[2], h0[3]); o.z = cvt_pk_bf16(h1[0], h1[1]); o.w = cvt_pk_bf16(h1[2], h1[3]); *(u32x4*)(HBio + off) = o; } }
        if (!OUT_F32) { ss2 = wave_sum(ss2); if (lane == 0) rstd_out[row] = rsqrtf(ss2 * (1.f / DM) + EPS); }
    }
}

constexpr int LDS_BYTES = 147456;
constexpr int NPH = 21;

#ifndef PHMASK
#define PHMASK 0xffffffffu
#endif
typedef const __attribute__((address_space(4))) Args* ArgsP;
#define PHASE_BEGIN ArgsP ap = (ArgsP)__builtin_amdgcn_kernarg_segment_ptr(); asm volatile("" : "+s"(ap) :: "memory"); unsigned char* ws = ap->ws; \
    int tid_ = threadIdx.x, bx_ = blockIdx.x; asm volatile("" : "+v"(tid_), "+s"(bx_)); const int tid = tid_, lane = tid & 63, wave = __builtin_amdgcn_readfirstlane(tid >> 6); const int G = gridDim.x, bx = bx_; \
    const int gw = bx * 8 + wave, NGW = G * 8, gt = bx * 512 + tid, NGT = G * 512; (void)lane; (void)gw; (void)NGW; (void)gt; (void)NGT; (void)ws;
using SO = pg8::StaticOrder;
using EN_TF = EpiNorm<true, false>; using EN_FF = EpiNorm<false, false>; using EN_FT = EpiNorm<false, true>;
#define RUN_GEMM(EPI, e, A_, B_, lda_, ldb_, K_, M_, N_, cidx) do { pg8::Gemm g_{A_, B_, lda_, ldb_, K_, 0, 0}; SO S_; S_.init(M_, N_, G, cidx); \
        pg8::gemm_phase<EPI, SO, true, true>(ldsl, g_, S_, e); } while (0)
#define WSP(T_, off) ((T_*)(ws + (off)))

__global__ void __launch_bounds__(512, 2) fwd_mega(Args args_unused) {
    extern __shared__ __attribute__((aligned(16))) unsigned char lds[];
    LAS unsigned char* ldsl = (LAS unsigned char*)lds;
    volatile LAS unsigned* bst = (volatile LAS unsigned*)(ldsl + 131072 + 64);
    if (threadIdx.x < 4) bst[threadIdx.x] = 0u;
    __syncthreads();
    { ArgsP ap0 = (ArgsP)__builtin_amdgcn_kernarg_segment_ptr(); (void)xcd_barrier_post((unsigned*)(ap0->ws + WS_BAR), bst); }
#define SEAM() do { ArgsP apb_ = (ArgsP)__builtin_amdgcn_kernarg_segment_ptr(); asm volatile("" : "+s"(apb_) :: "memory"); XcdBarrier b_; b_.bar = (unsigned*)(apb_->ws + WS_BAR); b_.x = xb_xcc_id(); b_.st = bst; xcd_barrier(b_); } while (0)

    if ((PHMASK >> 0) & 1) { PHASE_BEGIN
        float* ssq_cq = WSP(float, WS_SSQCQ); float* ssq_lat = WSP(float, WS_SSQLAT); float* cosT = WSP(float, WS_COS); float* sinT = WSP(float, WS_SIN);
        for (int i = gt; i < T; i += NGT) { ssq_cq[i] = 0.f; ssq_lat[i] = 0.f; }
        for (int i = gt; i < (int)((WS_CTL_ZERO_END - WS_SSQY) / 4); i += NGT) ((unsigned*)(ws + WS_SSQY))[i] = 0u;
        { const int* pos = ap->pos;
        for (int i = gt; i < T * 32; i += NGT) { const int t = i >> 5, f = i & 31; const float ang = (float)pos[t] * ap->invf[f];
            double rev = (double)ang * 0.15915494309189535; rev -= rint(rev); const float rf = (float)rev;
            cosT[i] = __builtin_amdgcn_cosf(rf); sinT[i] = __builtin_amdgcn_sinf(rf); } }
        { u32x4 z = {0u, 0u, 0u, 0u};
          u32x4* p = (u32x4*)(ws + WS_WBIN + (size_t)1856 * 2048 * 2); for (int i = gt; i < 192 * 2048 * 2 / 16; i += NGT) p[i] = z;
          for (int i = gt; i < 3072 * 16; i += NGT) { const int row = i >> 4, c = i & 15; const int pnr = (row >> 8) & 1;
              *(u32x4*)(ws + WS_WGATE + ((size_t)row * 256 + (1 - pnr) * 128) * 2 + c * 16) = z; } }
        cvt_rows(ap->x, WSP(bf16_t, WS_HB), WSP(float, WS_RSTD), T, gw, NGW, lane);
        cvt_rows(ap->mem, WSP(bf16_t, WS_MEMB), WSP(float, WS_RSTDMEM), 1024, gw, NGW, lane);
        LAS float* scr = (LAS float*)(ldsl + wave * 16384);
        int it = gw;
#define JOB(W_, ldw_, scol_, ncols_, K_, gain_, dst_, ldk_, koff_, kind_, rbase_) tr_job(it, NGW, W_, ldw_, scol_, ncols_, K_, gain_, (bf16_t*)(ws + (dst_)), ldk_, koff_, kind_, rbase_, scr, lane);
#define JOBF(W_, ldw_, scol_, ncols_, K_, gain_, dst_, ldk_, koff_, kind_, rbase_) tr_job(it, NGW, W_, ldw_, scol_, ncols_, K_, gain_, (bf16_t*)(ws + (dst_)), ldk_, koff_, kind_, rbase_, scr, lane, true);
        JOB(ap->a_w_in, 3584, 0, 3584, 2048, ap->g_mix_pre, WS_WAIN, 2048, 0, 0, 0)
        JOB(ap->w_o, 2048, 0, 2048, 2048, nullptr, WS_WO0, 2048, 0, 0, 0)
        JOB(ap->w_ff1, 8192, 0, 8192, 2048, ap->g_mlp_pre, WS_WFF1_0, 2048, 0, 0, 0)
        JOB(ap->w_ff2, 2048, 0, 2048, 8192, nullptr, WS_WFF2_0, LDF, 0, 0, 0)
        JOB(ap->w_mem_k, 512, 0, 512, 2048, ap->g_mem, WS_WMEM0, 2048, 0, 0, 0)
        JOB(ap->w_mem_v, 512, 0, 512, 2048, ap->g_mem, WS_WMEM0, 2048, 0, 0, 512)
        JOB(ap->w_mem_k + 2048 * 512, 512, 0, 512, 2048, ap->g_mem + 2048, WS_WMEM1, 2048, 0, 0, 0)
        JOB(ap->w_mem_v + 2048 * 512, 512, 0, 512, 2048, ap->g_mem + 2048, WS_WMEM1, 2048, 0, 0, 512)
        JOBF(ap->w_o + 2048 * 2048, 2048, 0, 2048, 2048, nullptr, WS_WO1, 2048, 0, 0, 0)
        JOBF(ap->w_ff1 + 2048 * 8192, 8192, 0, 8192, 2048, ap->g_mlp_pre + 2048, WS_WFF1_1, 2048, 0, 0, 0)
        JOBF(ap->b_w_in, 1280, 0, 1280, 2048, ap->g_mix_pre + 2048, WS_WBIN, 2048, 0, 0, 0)
        JOBF(ap->kv_w_down, 576, 0, 512, 2048, ap->kv_g_in, WS_WBIN, 2048, 0, 0, 1280)
        JOBF(ap->kv_w_down, 576, 512, 64, 2048, ap->kv_g_in, WS_WBIN, 2048, 0, 2, 1792)
        JOBF(ap->b_w_qb, 2304, 0, 2304, 768, ap->b_g_qa, WS_WQB, 768, 0, 1, 0)
        JOBF(ap->kv_w_up, 3072, 0, 3072, 512, ap->kv_g_latent, WS_WUP, 512, 0, 0, 0)
        for (int blk = 0; blk < 12; ++blk) {
            JOB(ap->a_w_r + blk * 16384, 128, 0, 128, 128, nullptr, WS_WGATE + (size_t)(blk >> 1) * 512 * 256 * 2, 256, (blk & 1) * 128, 0, (blk & 1) * 256)
            JOB(ap->a_w_i + blk * 16384, 128, 0, 128, 128, nullptr, WS_WGATE + (size_t)(blk >> 1) * 512 * 256 * 2, 256, (blk & 1) * 128, 0, (blk & 1) * 256 + 128)
        }
#undef JOB
#undef JOBF
        __syncthreads();
    }
    cg::this_grid().sync();

    if ((PHMASK >> 1) & 1) { PHASE_BEGIN
        { EpiA1 e{WSP(bf16_t, WS_XBR), WSP(bf16_t, WS_GG), WSP(bf16_t, WS_QMA), WSP(const float, WS_RSTD)};
          RUN_GEMM(EpiA1, e, WSP(const bf16_t, WS_HB), WSP(const bf16_t, WS_WAIN), 2048, 2048, 2048, T, 3584, bx); }
        { EpiStd<0> e{WSP(bf16_t, WS_MEMKV), 1024, WSP(const float, WS_RSTDMEM), 0.f, 1.f};
          RUN_GEMM(EpiStd<0>, e, WSP(const bf16_t, WS_MEMB), WSP(const bf16_t, WS_WMEM0), 2048, 2048, 2048, 1024, 1024, (bx + G - 128 % G) % G); }
        { EpiStd<0> e{WSP(bf16_t, WS_MEMKV + 2 * MiB), 1024, WSP(const float, WS_RSTDMEM), 0.f, 1.f};
          RUN_GEMM(EpiStd<0>, e, WSP(const bf16_t, WS_MEMB), WSP(const bf16_t, WS_WMEM1), 2048, 2048, 2048, 1024, 1024, (bx + G - 144 % G) % G); }
        { const int nidle = G > 160 ? G - 160 : G, first = G > 160 ? 160 : 0;
          if (bx >= first) { LAS float* scr = (LAS float*)(ldsl + wave * 16384); int it = (bx - first) * 8 + wave;
              tr_job(it, nidle * 8, ap->w_ff2 + 2048 * 8192, 2048, 0, 2048, 8192, nullptr, WSP(bf16_t, WS_WFF2_1), LDF, 0, 0, 0, scr, lane, true); } }
    }
    SEAM();

    if ((PHMASK >> 2) & 1) { PHASE_BEGIN
        const bf16_t* xbr = WSP(const bf16_t, WS_XBR); bf16_t* xc = WSP(bf16_t, WS_XC); const float* cw = ap->a_conv_w; const float* cb = ap->a_conv_b;
        for (int task = gt; task < 512 * 192; task += NGT) { const int r = task / 192, c8 = (task - r * 192) * 8, t0 = r * 32;
            f32x4 wl[4], wh[4];
#pragma unroll
            for (int j = 0; j < 4; ++j) { wl[j] = *(const f32x4*)(cw + j * 1536 + c8); wh[j] = *(const f32x4*)(cw + j * 1536 + c8 + 4); }
            const f32x4 bl = *(const f32x4*)(cb + c8), bh = *(const f32x4*)(cb + c8 + 4);
            const bf16_t* xp = xbr + (size_t)t0 * 1536 + c8; bf16_t* op = xc + (size_t)t0 * 1536 + c8;
            u32x4 x0 = {0u, 0u, 0u, 0u}, x1 = x0, x2 = x0;
            if ((t0 & (SEQ - 1)) != 0) { x0 = *(const u32x4*)(xp - 3 * 1536); x1 = *(const u32x4*)(xp - 2 * 1536); x2 = *(const u32x4*)(xp - 1536); }
#define CMAC(al, ah, wlo, whi, xv) do { al[0] += wlo[0] * bflo(xv.x); al[1] += wlo[1] * bfhi(xv.x); al[2] += wlo[2] * bflo(xv.y); al[3] += wlo[3] * bfhi(xv.y); \
                ah[0] += whi[0] * bflo(xv.z); ah[1] += whi[1] * bfhi(xv.z); ah[2] += whi[2] * bflo(xv.w); ah[3] += whi[3] * bfhi(xv.w); } while (0)
#pragma unroll 8
            for (int s = 0; s < 32; ++s) { const u32x4 x3 = *(const u32x4*)(xp + (size_t)s * 1536);
                f32x4 a0 = bl, a1 = bh;
                CMAC(a0, a1, wl[0], wh[0], x0); CMAC(a0, a1, wl[1], wh[1], x1); CMAC(a0, a1, wl[2], wh[2], x2); CMAC(a0, a1, wl[3], wh[3], x3);
                u32x4 o; o.x = cvt_pk_bf16(a0[0], a0[1]); o.y = cvt_pk_bf16(a0[2], a0[3]); o.z = cvt_pk_bf16(a1[0], a1[1]); o.w = cvt_pk_bf16(a1[2], a1[3]);
                *(u32x4*)(op + (size_t)s * 1536) = o; x0 = x1; x1 = x2; x2 = x3; }
#undef CMAC
        }
        __syncthreads();
        for (int u = bx; u < 256; u += G) { const int qb = u & 15, h = (u >> 4) & 3, b = u >> 6;
            const bf16_t* mkv = WSP(const bf16_t, WS_MEMKV) + (size_t)(b * 256) * 1024 + h * 128;
            AttnArgs a{WSP(const bf16_t, WS_QMA) + (size_t)(b * SEQ + qb * 256) * 512 + h * 128, 512, mkv, 1024, nullptr, mkv + 512, 1024,
                       WSP(bf16_t, WS_CC) + (size_t)(b * SEQ + qb * 256) * DM + 1536 + h * 128, DM, 4, 1 << 20};
            attn_unit<8>(a, (char*)lds); }
    }
    SEAM();

    if ((PHMASK >> 3) & 1) { PHASE_BEGIN
        EpiGate e{WSP(const bf16_t, WS_XC), ap->a_b_r, ap->a_b_i, WSP(unsigned, WS_RU)};
        pg8::Gemm g_{WSP(const bf16_t, WS_XC), WSP(const bf16_t, WS_WGATE), 1536, 256, 256, 512, (size_t)512 * 256 * 2};
        SO S_; S_.init(T, 3072, G, bx, 2);
        pg8::gemm_phase<EpiGate, SO, true, true>(ldsl, g_, S_, e);
    }
    SEAM();

    if ((PHMASK >> 4) & 1) { PHASE_BEGIN
        const unsigned* RU = WSP(const unsigned, WS_RU); float2* agg = WSP(float2, WS_AGG); const float* lam = ap->a_lambda;
        for (int u = bx; u < 768; u += G) { const int slab = u % 3, k = (u / 3) & 63, b = u / 192, ch = slab * 512 + tid;
            const float c2 = -8.f * 1.4426950408889634f * log1pf(__expf(-lam[ch]));
            const unsigned* p = RU + (size_t)(b * SEQ + k * 64) * 1536 + ch; float Aa = 1.f, Bb = 0.f;
            unsigned wv[64];
#pragma unroll
            for (int i = 0; i < 64; ++i) wv[i] = p[(size_t)i * 1536];
#pragma unroll
            for (int i = 0; i < 64; ++i) { const unsigned w = wv[i]; const float a = __builtin_amdgcn_exp2f(bflo(w) * c2);
                const float bb = sqrtf(fmaxf(1.f - a * a, 0.f)) * bfhi(w); Bb = a * Bb + bb; Aa *= a; }
            agg[(size_t)(b * 64 + k) * 1536 + ch] = make_float2(Aa, Bb); }
    }
    SEAM();

    if ((PHMASK >> 5) & 1) { PHASE_BEGIN
        const unsigned* RU = WSP(const unsigned, WS_RU); const float2* agg = WSP(const float2, WS_AGG); const bf16_t* gg = WSP(const bf16_t, WS_GG); const float* lam = ap->a_lambda;
        for (int u = bx; u < 768; u += G) { const int slab = u % 3, k = (u / 3) & 63, b = u / 192, ch = slab * 512 + tid;
            const float c2 = -8.f * 1.4426950408889634f * log1pf(__expf(-lam[ch]));
            float h = 0.f;
            for (int kk = 0; kk < k; kk += 8) { float2 ab[8];
#pragma unroll
                for (int j = 0; j < 8; ++j) ab[j] = (kk + j < k) ? agg[(size_t)(b * 64 + kk + j) * 1536 + ch] : make_float2(1.f, 0.f);
#pragma unroll
                for (int j = 0; j < 8; ++j) h = ab[j].x * h + ab[j].y; }
            const size_t r0 = (size_t)(b * SEQ + k * 64);
            const unsigned* p = RU + r0 * 1536 + ch; const bf16_t* gp = gg + r0 * 1536 + ch; bf16_t* op = WSP(bf16_t, WS_CC) + r0 * DM + ch;
            unsigned wv[64]; bf16_t gvv[64];
#pragma unroll
            for (int i = 0; i < 64; ++i) wv[i] = p[(size_t)i * 1536];
#pragma unroll
            for (int i = 0; i < 64; ++i) gvv[i] = gp[(size_t)i * 1536];
#pragma unroll
            for (int i = 0; i < 64; ++i) { const unsigned w = wv[i]; const float a = __builtin_amdgcn_exp2f(bflo(w) * c2);
                const float bb = sqrtf(fmaxf(1.f - a * a, 0.f)) * bfhi(w); h = a * h + bb;
                const float gv = __uint_as_float((unsigned)gvv[i] << 16);
                op[(size_t)i * DM] = (bf16_t)(cvt_pk_bf16(h * gv, 0.f) & 0xffffu); } }
    }
    SEAM();

#pragma unroll
    for (int layer = 0; layer < 2; ++layer) {
        if (layer == 1) {
            if ((PHMASK >> 6) & 1) { PHASE_BEGIN
                EpiB1 e{WSP(bf16_t, WS_CQ), WSP(bf16_t, WS_QMB), WSP(bf16_t, WS_CKV), WSP(bf16_t, WS_KPE), WSP(float, WS_SSQCQ), WSP(float, WS_SSQLAT), WSP(const float, WS_SSQH) + T, WSP(const float, WS_COS), WSP(const float, WS_SIN)};
                RUN_GEMM(EpiB1, e, WSP(const bf16_t, WS_HB), WSP(const bf16_t, WS_WBIN), 2048, 2048, 2048, T, 2048, bx);
            }
            SEAM();
            if ((PHMASK >> 7) & 1) { PHASE_BEGIN
                { EpiStd<0> e{WSP(bf16_t, WS_KV), 3072, WSP(const float, WS_SSQLAT), 1.f / 512.f, 1.f};
                  RUN_GEMM(EpiStd<0>, e, WSP(const bf16_t, WS_CKV), WSP(const bf16_t, WS_WUP), 512, 512, 512, T, 3072, bx); }
                { EpiQ e{WSP(bf16_t, WS_Q), WSP(const float, WS_SSQCQ), WSP(const float, WS_COS), WSP(const float, WS_SIN)};
                  RUN_GEMM(EpiQ, e, WSP(const bf16_t, WS_CQ), WSP(const bf16_t, WS_WQB), 768, 768, 768, T, 2304, bx); }
            }
            SEAM();
            if ((PHMASK >> 8) & 1) { PHASE_BEGIN
                for (int slot = 0; slot < (G == 256 ? ATT_SLOTS : 1024 / G + 1); ++slot) {
                    int code;
                    if (G == 256) code = g_att_sched[bx][slot]; else { const int p = slot * G + bx; code = p < 1024 ? (p < 768 ? p : 1024 + (p - 768)) : 0xFFFF; }
                    if (code == 0xFFFF) continue;
                    if (code < 1024) { const int qb = code & 15, bh = code >> 4, b = bh / 12, h = bh - b * 12;
                        const bf16_t* kv = WSP(const bf16_t, WS_KV) + (size_t)(b * SEQ) * 3072 + h * 256;
                        AttnArgs a{WSP(const bf16_t, WS_Q) + (size_t)(b * SEQ + qb * 256) * 2304 + h * 192, 2304, kv, 3072, WSP(const bf16_t, WS_KPE) + (size_t)(b * SEQ) * 64,
                                   kv + 128, 3072, WSP(bf16_t, WS_CC) + (size_t)(b * SEQ + qb * 256) * DM + h * 128, DM, 4 * qb + 4, 4 * qb};
                        attn_unit<12>(a, (char*)lds); }
                    else { const int u = code - 1024, qb = u & 15, h = (u >> 4) & 3, b = u >> 6;
                        const bf16_t* mkv = WSP(const bf16_t, WS_MEMKV + 2 * MiB) + (size_t)(b * 256) * 1024 + h * 128;
                        AttnArgs a{WSP(const bf16_t, WS_QMB) + (size_t)(b * SEQ + qb * 256) * 512 + h * 128, 512, mkv, 1024, nullptr, mkv + 512, 1024,
                                   WSP(bf16_t, WS_CC) + (size_t)(b * SEQ + qb * 256) * DM + 1536 + h * 128, DM, 4, 1 << 20};
                        attn_unit<8>(a, (char*)lds); }
                }
            }
            SEAM();
        }
        const size_t wo_off = layer ? WS_WO1 : WS_WO0, wf1_off = layer ? WS_WFF1_1 : WS_WFF1_0, wf2_off = layer ? WS_WFF2_1 : WS_WFF2_0;
#pragma unroll
        for (int hf = 0; hf < 2; ++hf) {
            if ((PHMASK >> 10) & 1) { PHASE_BEGIN
                LAS float* Pl = (LAS float*)(ldsl + 131072 + 1024);
                if (layer == 0) { EpiNorm<true, false> e{ap->x, WSP(bf16_t, WS_HB), nullptr, ap->g_mix_post, WSP(float, WS_SSQY), WSP(float, WS_SSQH), WSP(unsigned, WS_CNT), hf * 8192, Pl};
                    RUN_GEMM(EN_TF, e, WSP(const bf16_t, WS_CC) + (size_t)hf * 8192 * DM, (const bf16_t*)(ws + wo_off), 2048, 2048, 2048, 8192, 2048, bx); }
                else { EpiNorm<false, false> e{nullptr, WSP(bf16_t, WS_HB), nullptr, ap->g_mix_post + DM, WSP(float, WS_SSQY) + 2 * T, WSP(float, WS_SSQH) + 2 * T, WSP(unsigned, WS_CNT) + 2 * 64 * 64, hf * 8192, Pl};
                    RUN_GEMM(EN_FF, e, WSP(const bf16_t, WS_CC) + (size_t)hf * 8192 * DM, (const bf16_t*)(ws + wo_off), 2048, 2048, 2048, 8192, 2048, bx); }
            }
            if (hf == 1) SEAM();
        }
#pragma unroll
        for (int hf = 0; hf < 2; ++hf) {
            if ((PHMASK >> 12) & 1) { PHASE_BEGIN EpiStd<2> e{WSP(bf16_t, WS_F), LDF, WSP(const float, WS_SSQH) + (layer * 2) * T + hf * 8192, 1.f / DM, 1.f};
                RUN_GEMM(EpiStd<2>, e, WSP(const bf16_t, WS_HB) + (size_t)hf * 8192 * DM, (const bf16_t*)(ws + wf1_off), 2048, 2048, 2048, 8192, 8192, bx); }
            SEAM();
            if ((PHMASK >> 13) & 1) { PHASE_BEGIN
                LAS float* Pl = (LAS float*)(ldsl + 131072 + 1024);
                if (layer == 0) { EpiNorm<false, false> e{nullptr, WSP(bf16_t, WS_HB), nullptr, ap->g_mlp_post, WSP(float, WS_SSQY) + T, WSP(float, WS_SSQH) + T, WSP(unsigned, WS_CNT) + 64 * 64, hf * 8192, Pl};
                    RUN_GEMM(EN_FF, e, WSP(const bf16_t, WS_F), (const bf16_t*)(ws + wf2_off), LDF, LDF, 8192, 8192, 2048, bx); }
                else { EpiNorm<false, true> e{nullptr, WSP(bf16_t, WS_HB), ap->out, ap->g_mlp_post + DM, WSP(float, WS_SSQY) + 3 * T, WSP(float, WS_SSQH) + 3 * T, WSP(unsigned, WS_CNT) + 3 * 64 * 64, hf * 8192, Pl};
                    RUN_GEMM(EN_FT, e, WSP(const bf16_t, WS_F), (const bf16_t*)(ws + wf2_off), LDF, LDF, 8192, 8192, 2048, bx); }
            }
            if (!(layer == 1 && hf == 1)) SEAM();
        }
    }
#undef SEAM
}

extern "C" void kernel_launch(void* const* d_in, const int* in_sizes, int n_in, void* d_out, int out_size, void* d_ws, size_t ws_size, hipStream_t stream) {
    static int grid = 0;
    if (grid == 0) {
        if (n_in != 28 || in_sizes[0] != T * DM || out_size != T * DM || ws_size < WS_END) {
            fprintf(stderr, "kernel_launch: unexpected shapes: n_in %d in0 %d out %d ws %zu (need %zu)\n", n_in, n_in > 0 ? in_sizes[0] : -1, out_size, ws_size, (size_t)WS_END); grid = -1; return; }
        int dev = 0, cus = 0, per_cu = 0;
        (void)hipGetDevice(&dev); (void)hipDeviceGetAttribute(&cus, hipDeviceAttributeMultiprocessorCount, dev);
        if (hipFuncSetAttribute((const void*)fwd_mega, hipFuncAttributeMaxDynamicSharedMemorySize, LDS_BYTES) != hipSuccess) fprintf(stderr, "kernel_launch: hipFuncSetAttribute failed\n");
        if (hipOccupancyMaxActiveBlocksPerMultiprocessor(&per_cu, (const void*)fwd_mega, 512, LDS_BYTES) != hipSuccess || per_cu < 1) { fprintf(stderr, "kernel_launch: occupancy query says %d\n", per_cu); per_cu = 1; }
        (void)hipGetLastError();
        grid = cus * 1;
        if (grid <= 0) grid = 256;
    }
    if (grid < 0) return;
    Args a{};
    a.x = (const float*)d_in[0]; a.mem = (const float*)d_in[1]; a.pos = (const int*)d_in[2];
    a.g_mix_pre = (const float*)d_in[3]; a.g_mix_post = (const float*)d_in[4]; a.g_mlp_pre = (const float*)d_in[5]; a.g_mlp_post = (const float*)d_in[6]; a.g_mem = (const float*)d_in[7];
    a.w_mem_k = (const float*)d_in[8]; a.w_mem_v = (const float*)d_in[9]; a.w_o = (const float*)d_in[10]; a.w_ff1 = (const float*)d_in[11]; a.w_ff2 = (const float*)d_in[12];
    a.a_w_in = (const float*)d_in[13]; a.a_conv_w = (const float*)d_in[14]; a.a_conv_b = (const float*)d_in[15]; a.a_w_r = (const float*)d_in[16]; a.a_b_r = (const float*)d_in[17];
    a.a_w_i = (const float*)d_in[18]; a.a_b_i = (const float*)d_in[19]; a.a_lambda = (const float*)d_in[20];
    a.b_w_in = (const float*)d_in[21]; a.b_g_qa = (const float*)d_in[22]; a.b_w_qb = (const float*)d_in[23];
    a.kv_g_in = (const float*)d_in[24]; a.kv_w_down = (const float*)d_in[25]; a.kv_g_latent = (const float*)d_in[26]; a.kv_w_up = (const float*)d_in[27 + 0];
    a.out = (float*)d_out; a.ws = (unsigned char*)d_ws;
    for (int i = 0; i < 32; ++i) a.invf[i] = (float)pow(10000.0, -(double)i / 32.0);
    a.ph_lo = 0; a.ph_hi = 1000;
    (void)hipMemsetAsync((unsigned char*)d_ws + WS_BAR, 0, 16384, stream);
    void* kargs[] = {&a};
    hipError_t e = hipLaunchCooperativeKernel((const void*)fwd_mega, dim3(grid), dim3(512), kargs, LDS_BYTES, stream);
    if (e != hipSuccess) fprintf(stderr, "kernel_launch: cooperative launch failed: %s (grid %d)\n", hipGetErrorString(e), grid);
}
```
